# Optimizing an MI355X kernel written in HIP

```python
import jax, jax.numpy as jnp
from jax import lax
import numpy as np

D_MODEL = 1024
BATCH = 8
SEQ = 2048
DEPTH = 4

CHUNK = 128
A_WIDTH = D_MODEL
A_GROUPS = 8
A_GROUP_DIM = A_WIDTH // A_GROUPS
N_HEADS = 16
HEAD_DIM = 64
B_WIDTH = N_HEADS * HEAD_DIM
DILATED_PATTERNS = ((128, 1), (512, 4), (2048, 16))
BLOCK = 128
N_BRANCHES = 2
EPS = 1e-6
NEG_INF = -1e30
IN_COLS = 3 * A_WIDTH + 4 * B_WIDTH + N_BRANCHES * D_MODEL

kernel_name = "hybrid_gmlp_dilated_attn_block"


def rmsnorm(x, g):
    xf = x.astype(jnp.float32)
    y = xf * lax.rsqrt(jnp.mean(xf * xf, axis=-1, keepdims=True) + EPS)
    return (y * g.astype(jnp.float32)).astype(x.dtype)


def chunked_spatial_gating(u, v, w_s, b_s, g_v):
    Bn, S, _ = v.shape
    v = rmsnorm(v, g_v)
    vc = v.reshape(Bn, S // CHUNK, CHUNK, A_GROUPS, A_GROUP_DIM)
    causal = jnp.tril(jnp.ones((CHUNK, CHUNK), dtype=bool))
    w = jnp.where(causal[None], w_s, 0).astype(v.dtype)
    mixed = jnp.einsum('gts,bcsgd->bctgd', w, vc) + b_s.T[None, None, :, :, None]
    return u * mixed.reshape(Bn, S, A_WIDTH)


def dilated_pattern(q, k, v, slopes, window, dilation):
    Bn, H, S, Dh = q.shape
    L = S // dilation
    nback = window // dilation
    nb = -(-L // BLOCK)
    pad = nb * BLOCK - L

    def to_blocks(t):
        t = t.reshape(Bn, H, L, dilation, Dh).transpose(0, 1, 3, 2, 4)
        t = jnp.pad(t, ((0, 0), (0, 0), (0, 0), (0, pad), (0, 0)))
        return t.reshape(Bn, H, dilation, nb, BLOCK, Dh)

    qb, kb, vb = to_blocks(q), to_blocks(k), to_blocks(v)

    def with_prev(t):
        prev = jnp.pad(t, ((0, 0), (0, 0), (0, 0), (1, 0), (0, 0), (0, 0)))[:, :, :, :-1]
        return jnp.concatenate([prev, t], axis=4)

    kw, vw = with_prev(kb), with_prev(vb)
    qpos = jnp.arange(BLOCK)[:, None] + BLOCK
    kpos = jnp.arange(2 * BLOCK)[None, :]
    dist = qpos - kpos
    key_idx = (jnp.arange(nb)[:, None, None] - 1) * BLOCK + kpos[None]
    valid = (dist >= 0) & (dist <= nback) & (key_idx >= 0)

    s = jnp.einsum('bhrnqd,bhrnkd->bhrnqk', qb, kw) * (Dh ** -0.5)
    s = s - slopes[None, :, None, None, None, None] * (dist * dilation).astype(jnp.float32)
    s = jnp.where(valid[None, None, None], s, NEG_INF)
    m = jnp.max(s, axis=-1)
    p = jnp.exp(s - m[..., None])
    l = jnp.sum(p, axis=-1)
    o = jnp.einsum('bhrnqk,bhrnkd->bhrnqd', p, vw) / l[..., None]

    def from_blocks(t):
        t = t.reshape(Bn, H, dilation, nb * BLOCK, *t.shape[5:])[:, :, :, :L]
        t = jnp.moveaxis(t, 2, 3)
        return t.reshape(Bn, H, S, *t.shape[4:])

    return from_blocks(o), from_blocks(m), from_blocks(l)


def dilated_attention(q, k, v):
    Bn, S, _ = q.shape
    heads = lambda t: t.astype(jnp.float32).reshape(Bn, S, N_HEADS, HEAD_DIM).transpose(0, 2, 1, 3)
    qh, kh, vh = heads(q), heads(k), heads(v)
    slopes = 2.0 ** (-8.0 * jnp.arange(1, N_HEADS + 1, dtype=jnp.float32) / N_HEADS)
    outs = [dilated_pattern(qh, kh, vh, slopes, w, d) for (w, d) in DILATED_PATTERNS]
    m_all = jnp.max(jnp.stack([m for (_, m, _) in outs]), axis=0)
    alphas = [l * jnp.exp(m - m_all) for (_, m, l) in outs]
    num = sum(a[..., None] * o for a, (o, _, _) in zip(alphas, outs))
    o = num / sum(alphas)[..., None]
    return o.transpose(0, 2, 1, 3).reshape(Bn, S, B_WIDTH).astype(q.dtype)


def setup_inputs(seed: int = 0) -> dict:
    key = jax.random.key(seed)
    ks = jax.random.split(key, 10)
    f32 = jnp.float32
    x = jax.random.normal(ks[0], (BATCH, SEQ, D_MODEL), f32)
    g_norm = 1.0 + 0.05 * jax.random.normal(ks[1], (DEPTH, D_MODEL), f32)
    w_in = jax.random.normal(ks[2], (DEPTH, D_MODEL, IN_COLS), f32) * D_MODEL ** -0.5
    w_s = jax.random.normal(ks[3], (DEPTH, A_GROUPS, CHUNK, CHUNK), f32) * CHUNK ** -0.5
    b_s = 1.0 + 0.1 * jax.random.normal(ks[4], (DEPTH, A_GROUPS, CHUNK), f32)
    g_v = 1.0 + 0.05 * jax.random.normal(ks[5], (DEPTH, A_WIDTH), f32)
    w_proj_a = jax.random.normal(ks[6], (DEPTH, A_WIDTH, D_MODEL), f32) * A_WIDTH ** -0.5
    w_proj_b = jax.random.normal(ks[7], (DEPTH, B_WIDTH, D_MODEL), f32) * B_WIDTH ** -0.5
    w_out = jax.random.normal(ks[8], (DEPTH, D_MODEL, D_MODEL), f32) * D_MODEL ** -0.5
    g_final = 1.0 + 0.05 * jax.random.normal(ks[9], (D_MODEL,), f32)
    return {"x": x, "g_norm": g_norm, "w_in": w_in, "w_s": w_s, "b_s": b_s, "g_v": g_v,
            "w_proj_a": w_proj_a, "w_proj_b": w_proj_b, "w_out": w_out, "g_final": g_final}


def reference(x, g_norm, w_in, w_s, b_s, g_v, w_proj_a, w_proj_b, w_out, g_final):
    splits = [A_WIDTH, 2 * A_WIDTH, 3 * A_WIDTH,
              3 * A_WIDTH + B_WIDTH, 3 * A_WIDTH + 2 * B_WIDTH,
              3 * A_WIDTH + 3 * B_WIDTH, 3 * A_WIDTH + 4 * B_WIDTH]
    for layer in range(DEPTH):
        h = rmsnorm(x, g_norm[layer])
        proj = h @ w_in[layer]
        a_u, a_v, a_gate, q, k, v, b_gate, gate_logits = jnp.split(proj, splits, axis=-1)
        y_a = chunked_spatial_gating(jax.nn.gelu(a_u), jax.nn.gelu(a_v),
                                     w_s[layer], b_s[layer], g_v[layer]) * jax.nn.silu(a_gate)
        y_b = dilated_attention(q, k, v) * jax.nn.silu(b_gate)
        g_a, g_b = jnp.split(jax.nn.sigmoid(gate_logits), N_BRANCHES, axis=-1)
        merged = g_a * (y_a @ w_proj_a[layer]) + g_b * (y_b @ w_proj_b[layer])
        x = x + merged @ w_out[layer]
    return rmsnorm(x, g_final)
```

```cpp
#include <hip/hip_runtime.h>
#include <hip/hip_cooperative_groups.h>
#include <cstdio>
#include <cstdint>
namespace cg = cooperative_groups;
#define NAIVE_MASK 0
#ifndef NAIVE_COLMASK
#define NAIVE_COLMASK (0x40 << 8)
#endif
#ifndef MK_MULTI
#define MK_MULTI 1
#endif
namespace pg8 {
#define PG8_LAS __attribute__((address_space(3)))
typedef unsigned short bf16_t;
typedef short bf16x8 __attribute__((ext_vector_type(8)));
typedef float f32x4 __attribute__((ext_vector_type(4)));
typedef unsigned u32x4 __attribute__((ext_vector_type(4)));
constexpr int BM = 256, BK = 64, HALF = 128, HTB = HALF * BK * 2  , STAGE_BYTES = 8 * HTB, NXCD = 8, WGM = 8;

__host__ __device__ __forceinline__ int lds_byte(int r, int c) { const int st = (r >> 4) * 2 + (c >> 5), rr = r & 15, cc = c & 31, ob = rr * 64 + cc * 2; return st * 1024 + (ob ^ (((ob >> 9) & 1) << 5)); }
__host__ __device__ __forceinline__ void stage_rc(int b, int& R, int& C) { const int st = b / 1024, sb = b % 1024, swz = sb ^ (((sb >> 9) & 1) << 5); R = (st >> 1) * 16 + swz / 64; C = (st & 1) * 32 + (swz % 64) / 2; }
__host__ __device__ __forceinline__ int perm32(int rho) { const int n = rho >> 4, i = rho & 15; return 8 * (i >> 2) + 4 * n + (i & 3); }

struct Unit { int pm, pn; };
struct Gemm { const bf16_t* A; const bf16_t* Bt; int M, N, K; };

struct StaticOrder {
    int nM, nN, nwg, G, c;
    __host__ __device__ void init(int M, int N, int G_, int c_) { nM = M / BM; nN = N / BM; nwg = nM * nN; G = G_; c = c_; }
    __host__ __device__ bool next(int i, Unit& u) const {
        const long L = (long)i * G + c; if (L >= nwg) return false;
        int wgid = (int)L; { const int q = nwg / NXCD, r = nwg % NXCD, xcd = wgid % NXCD, off = wgid / NXCD; wgid = (xcd < r ? xcd * (q + 1) : r * (q + 1) + (xcd - r) * q) + off; }
        const int nig = WGM * nN, gid = wgid / nig, fm = gid * WGM, gsz = (nM - fm) < WGM ? (nM - fm) : WGM;
        u.pm = fm + ((wgid % nig) % gsz); u.pn = (wgid % nig) / gsz; return true;
    }
    __device__ __forceinline__ void a_ready(const Unit&) const {}
    __device__ __forceinline__ void done(const Unit&) const {}
};
__device__ __forceinline__ unsigned cvt_pk_bf16(float lo, float hi) { unsigned r; asm volatile("v_cvt_pk_bf16_f32 %0, %1, %2" : "=v"(r) : "v"(lo), "v"(hi)); return r; }
template <class Epi, class Sched, bool ALIGN_EPI = false, bool SP2 = false>
__device__ __forceinline__ void gemm_phase(PG8_LAS unsigned char* lds, const Gemm g, const Sched& S, const Epi& E) {
    const int tid = threadIdx.x, wid = __builtin_amdgcn_readfirstlane(tid >> 6), lane = tid & 63, wr = wid >> 2, wc = wid & 3, fr = lane & 15, fq = lane >> 4;
    const int K = g.K, nt = K / BK;
    unsigned voffA[2], voffB[2];
#pragma unroll
    for (int i = 0; i < 2; ++i) { int R, C; stage_rc(tid * 16 + i * 8192, R, C); const int Rb = Epi::PERM ? ((R & ~31) + perm32(R & 31)) : R;
        voffA[i] = (unsigned)(R * K + C) * 2u; voffB[i] = (unsigned)(Rb * K + C) * 2u; }
    const size_t kstep = (size_t)(BK * 2);
    const size_t hstep = (size_t)HALF * K * 2;
    const size_t tstep = 2 * hstep;
    const unsigned ldsw = (unsigned)wid * 1024u;
    const int aoff = lds_byte(wr * 64 + fr, fq * 8), boff = lds_byte(wc * 32 + fr, fq * 8);
#define PG8_SA(b, h) (((b) * 2 + (h)) * HTB)
#define PG8_SB(b, h) ((4 + (b) * 2 + (h)) * HTB)
#define PG8_STAGE(bufoff, gbase, voff) do { _Pragma("unroll") for (int _i = 0; _i < 2; ++_i) \
        __builtin_amdgcn_global_load_lds((const unsigned*)((const char*)(gbase) + (voff)[_i]), (PG8_LAS unsigned*)(lds + (bufoff) + ldsw + _i * 8192), 16, 0, 0); } while (0)
#define PG8_LDA(dst, b, h) do { _Pragma("unroll") for (int m = 0; m < 4; ++m) _Pragma("unroll") for (int k = 0; k < 2; ++k) dst[m][k] = *(const PG8_LAS bf16x8*)(lds + PG8_SA(b, h) + aoff + m * 2048 + k * 1024); } while (0)
#define PG8_LDB(dst, b, h) do { _Pragma("unroll") for (int n = 0; n < 2; ++n) _Pragma("unroll") for (int k = 0; k < 2; ++k) dst[n][k] = *(const PG8_LAS bf16x8*)(lds + PG8_SB(b, h) + boff + n * 2048 + k * 1024); } while (0)
#define PG8_MMA(ai, bj, At, Bt) do { __builtin_amdgcn_s_setprio(1); _Pragma("unroll") for (int m = 0; m < 4; ++m) _Pragma("unroll") for (int n = 0; n < 2; ++n) _Pragma("unroll") for (int k = 0; k < 2; ++k) \
        acc[ai][bj][m][n] = __builtin_amdgcn_mfma_f32_16x16x32_bf16(Bt[n][k], At[m][k], acc[ai][bj][m][n], 0, 0, 0); __builtin_amdgcn_s_setprio(0); } while (0)
#define PG8_WAIT_V(n) asm volatile("s_waitcnt vmcnt(" #n ")" ::: "memory")
#define PG8_WAIT_L(n) asm volatile("s_waitcnt lgkmcnt(" #n ")" ::: "memory")
#define PG8_BAR __builtin_amdgcn_s_barrier()
#define PG8_SCHED __builtin_amdgcn_sched_barrier(0)
    Unit cur, nxt; int ui = 0;
    if (!S.next(0, cur)) return;
    f32x4 acc[2][2][4][2];
#pragma unroll
    for (int a = 0; a < 2; ++a)
#pragma unroll
        for (int b = 0; b < 2; ++b)
#pragma unroll
            for (int m = 0; m < 4; ++m)
#pragma unroll
                for (int n = 0; n < 2; ++n) acc[a][b][m][n] = (f32x4){0.f, 0.f, 0.f, 0.f};
    bf16x8 At[4][2], B0[2][2], B1[2][2];
    const char* cA = (const char*)g.A + (size_t)cur.pm * tstep; const char* cB = (const char*)g.Bt + (size_t)cur.pn * tstep;
    S.a_ready(cur);
    if constexpr (SP2) {
        PG8_STAGE(PG8_SB(0, 0), cB, voffB); PG8_STAGE(PG8_SB(0, 1), cB + hstep, voffB); PG8_STAGE(PG8_SA(0, 0), cA, voffA); PG8_STAGE(PG8_SA(0, 1), cA + hstep, voffA);
        if (wr == 1) PG8_BAR;
        PG8_WAIT_V(2); PG8_BAR;
        PG8_STAGE(PG8_SB(1, 0), cB + kstep, voffB); PG8_STAGE(PG8_SA(1, 0), cA + kstep, voffA); PG8_STAGE(PG8_SB(1, 1), cB + hstep + kstep, voffB);
        PG8_WAIT_V(6); PG8_BAR;
    } else {
        PG8_STAGE(PG8_SB(0, 0), cB, voffB); PG8_STAGE(PG8_SA(0, 0), cA, voffA); PG8_STAGE(PG8_SB(0, 1), cB + hstep, voffB); PG8_STAGE(PG8_SA(0, 1), cA + hstep, voffA);
        if (wr == 1) PG8_BAR;
        PG8_WAIT_V(4); PG8_BAR;
        PG8_STAGE(PG8_SB(1, 0), cB + kstep, voffB); PG8_STAGE(PG8_SA(1, 0), cA + kstep, voffA); PG8_STAGE(PG8_SB(1, 1), cB + hstep + kstep, voffB);
        PG8_WAIT_V(6); PG8_BAR;
    }
    for (;;) {
        const bool has_next = S.next(ui + 1, nxt);
        const char* nA = has_next ? (const char*)g.A + (size_t)nxt.pm * tstep : cA; const char* nB = has_next ? (const char*)g.Bt + (size_t)nxt.pn * tstep : cB;
        for (int t = 0; t < nt; t += 2) {
            const bool last = (t == nt - 2);
            const char* a1 = cA + (size_t)(t + 1) * kstep;
            const char* a2 = last ? nA : cA + (size_t)(t + 2) * kstep; const char* b2 = last ? nB : cB + (size_t)(t + 2) * kstep;
            const char* a3 = a2 + kstep; const char* b3 = b2 + kstep;
            if (last && has_next) S.a_ready(nxt);
            if constexpr (SP2) {
            PG8_LDB(B0, 0, 0); PG8_LDB(B1, 0, 1); PG8_SCHED; PG8_LDA(At, 0, 0); PG8_STAGE(PG8_SA(1, 1), a1 + hstep, voffA);
            PG8_WAIT_V(8); PG8_WAIT_L(0); PG8_BAR; PG8_MMA(0, 0, At, B0); PG8_MMA(0, 1, At, B1); PG8_BAR; PG8_SCHED;
            PG8_LDA(At, 0, 1); PG8_STAGE(PG8_SB(0, 0), b2, voffB); PG8_STAGE(PG8_SB(0, 1), b2 + hstep, voffB); PG8_STAGE(PG8_SA(0, 0), a2, voffA);
            PG8_WAIT_V(8); PG8_WAIT_L(0); PG8_BAR; PG8_MMA(1, 0, At, B0); PG8_MMA(1, 1, At, B1); PG8_BAR; PG8_SCHED;
            PG8_LDB(B0, 1, 0); PG8_LDB(B1, 1, 1); PG8_SCHED; PG8_LDA(At, 1, 0); PG8_STAGE(PG8_SA(0, 1), a2 + hstep, voffA);
            PG8_WAIT_V(8); PG8_WAIT_L(0); PG8_BAR; PG8_MMA(0, 0, At, B0); PG8_MMA(0, 1, At, B1); PG8_BAR; PG8_SCHED;
            PG8_LDA(At, 1, 1); PG8_STAGE(PG8_SB(1, 0), b3, voffB); PG8_STAGE(PG8_SB(1, 1), b3 + hstep, voffB); PG8_STAGE(PG8_SA(1, 0), a3, voffA);
            PG8_WAIT_V(8); PG8_WAIT_L(0); PG8_BAR; PG8_MMA(1, 0, At, B0); PG8_MMA(1, 1, At, B1); PG8_BAR; PG8_SCHED;
            } else {
            PG8_LDB(B0, 0, 0); PG8_SCHED; PG8_LDA(At, 0, 0); PG8_STAGE(PG8_SA(1, 1), a1 + hstep, voffA);
            PG8_WAIT_L(8); PG8_BAR; PG8_WAIT_L(0); PG8_MMA(0, 0, At, B0); PG8_BAR; PG8_SCHED;
            PG8_LDB(B1, 0, 1); PG8_STAGE(PG8_SB(0, 0), b2, voffB);
            PG8_BAR; PG8_WAIT_L(0); PG8_MMA(0, 1, At, B1); PG8_BAR;
            PG8_LDA(At, 0, 1); PG8_STAGE(PG8_SA(0, 0), a2, voffA);
            PG8_BAR; PG8_WAIT_L(0); PG8_MMA(1, 0, At, B0); PG8_BAR; PG8_SCHED;
            PG8_STAGE(PG8_SB(0, 1), b2 + hstep, voffB);
            PG8_WAIT_V(6); PG8_BAR; PG8_MMA(1, 1, At, B1); PG8_BAR;
            PG8_LDB(B0, 1, 0); PG8_SCHED; PG8_LDA(At, 1, 0); PG8_STAGE(PG8_SA(0, 1), a2 + hstep, voffA);
            PG8_WAIT_L(8); PG8_BAR; PG8_WAIT_L(0); PG8_MMA(0, 0, At, B0); PG8_BAR; PG8_SCHED;
            PG8_LDB(B1, 1, 1); PG8_STAGE(PG8_SB(1, 0), b3, voffB);
            PG8_BAR; PG8_WAIT_L(0); PG8_MMA(0, 1, At, B1); PG8_BAR;
            PG8_LDA(At, 1, 1); PG8_STAGE(PG8_SA(1, 0), a3, voffA);
            PG8_BAR; PG8_WAIT_L(0); PG8_MMA(1, 0, At, B0); PG8_BAR; PG8_SCHED;
            PG8_STAGE(PG8_SB(1, 1), b3 + hstep, voffB);
            PG8_WAIT_V(6); PG8_BAR; PG8_MMA(1, 1, At, B1); PG8_BAR;
            }
        }
        if constexpr (ALIGN_EPI) { if (wr == 0) PG8_BAR; }
        if constexpr (!Epi::AFTER_DRAIN) { E(acc, cur, wr, wc, fr, fq); S.done(cur); }
        if (!has_next) break;
#pragma unroll
        for (int a = 0; a < 2; ++a)
#pragma unroll
            for (int b = 0; b < 2; ++b)
#pragma unroll
                for (int m = 0; m < 4; ++m)
#pragma unroll
                    for (int n = 0; n < 2; ++n) acc[a][b][m][n] = (f32x4){0.f, 0.f, 0.f, 0.f};
        cur = nxt; cA = nA; cB = nB; ++ui;
        if constexpr (ALIGN_EPI) { if (wr == 1) PG8_BAR; }
    }
    PG8_WAIT_V(0);
    if constexpr (!ALIGN_EPI) { if (wr == 0) PG8_BAR; }
    PG8_BAR;
    if constexpr (Epi::AFTER_DRAIN) { E.fused(acc, cur, wr, wc, fr, fq, lds, wid, lane); S.done(cur); }
#undef PG8_SA
#undef PG8_SB
#undef PG8_STAGE
#undef PG8_LDA
#undef PG8_LDB
#undef PG8_MMA
#undef PG8_WAIT_V
#undef PG8_WAIT_L
#undef PG8_BAR
#undef PG8_SCHED
}
}
using pg8::bf16_t; using pg8::bf16x8; using pg8::f32x4; using pg8::u32x4;
typedef unsigned u32x2 __attribute__((ext_vector_type(2)));
constexpr int NWAVES = 8;
constexpr int M_TOK = 16384, DM = 1024, SEQ = 2048, DEPTH = 4, IN_COLS = 9216;
constexpr int N_MAIN = 7168, N_SW = 2048;
constexpr float EPS = 1e-6f;
constexpr float LOG2E = 1.4426950408889634f;
constexpr float QSCALE = 0.125f * LOG2E;
constexpr size_t MiB = 1u << 20;
constexpr size_t WS_XSQ = 0;
constexpr size_t WS_VSQ = 512 * 1024;
constexpr size_t WS_WM = 1 * MiB;
constexpr size_t WS_WT_MAIN = 2 * MiB;
constexpr size_t WS_WT_SW = 58 * MiB;
constexpr size_t WS_WT_A = 74 * MiB, WS_WT_B = 82 * MiB, WS_WT_O = 90 * MiB;
constexpr size_t WS_XB = 98 * MiB, WS_XBP = 130 * MiB;
constexpr size_t WS_ACT = 162 * MiB;
constexpr size_t ACT_STRIDE = (size_t)M_TOK * DM;
constexpr size_t WS_GVT = 386 * MiB, WS_VT = 418 * MiB;
constexpr size_t WS_T = 450 * MiB;
constexpr size_t WS_MG = 514 * MiB;
constexpr size_t WS_END = 546 * MiB;
constexpr int RING_BYTES = 131072, LDS_BYTES = 147456;

#define GAS __attribute__((address_space(1)))
#define LAS __attribute__((address_space(3)))

__device__ __forceinline__ float bf2f(unsigned short h) { return __builtin_bit_cast(float, (unsigned)h << 16); }
__device__ __forceinline__ float bflo(unsigned w) { return __builtin_bit_cast(float, w << 16); }
__device__ __forceinline__ float bfhi(unsigned w) { return __builtin_bit_cast(float, w & 0xffff0000u); }
__device__ __forceinline__ unsigned pkbf(float lo, float hi) { return pg8::cvt_pk_bf16(lo, hi); }
__device__ __forceinline__ float sigm(float z) { return __builtin_amdgcn_rcpf(1.f + __builtin_amdgcn_exp2f(-LOG2E * z)); }
__device__ __forceinline__ float gelu_t(float v) { const float z = 1.5957691216057308f * v * (1.f + 0.044715f * v * v); return v * sigm(z); }
__device__ __forceinline__ float rs_of(float ss) { return __builtin_amdgcn_rsqf(ss * (1.0f / 1024.0f) + EPS); }
__device__ __forceinline__ int pi_row(int row) { return (row & ~2047) | ((row & 3) << 9) | ((row & 2047) >> 2); }
__device__ __forceinline__ int pi_inv(int p) { return (p & ~2047) | ((p & 511) << 2) | ((p >> 9) & 3); }

struct EpiMain {
    static constexpr bool PERM = true, AFTER_DRAIN = false;
    bf16_t* O; const float* xsq;
    __device__ __forceinline__ void operator()(const f32x4 (&acc)[2][2][4][2], const pg8::Unit& u, int wr, int wc, int fr, int fq) const {
        asm volatile("" : "+v"(fr), "+v"(fq));
        const int seg = u.pn >> 2;
        bf16_t* base = O + (size_t)seg * ACT_STRIDE;
        const int col0 = (u.pn & 3) * 256 + wc * 32 + 8 * fq, row0 = u.pm * 256 + wr * 64 + fr;
        const float kz0 = seg == 0 ? 1.5957691216057308f : 1.f, kz1 = seg == 0 ? 1.5957691216057308f * 0.044715f : 0.f;
        const float ka = seg == 2 ? QSCALE : (seg == 3 ? 1.f : 0.f), kb = (seg == 0 || seg == 1 || seg == 4) ? 1.f : 0.f, kc = seg >= 5 ? 1.f : 0.f;
#pragma unroll
        for (int ai = 0; ai < 2; ++ai)
#pragma unroll
            for (int m = 0; m < 4; ++m) { const int row = row0 + ai * 128 + m * 16; const float rs = rs_of(xsq[row]); bf16_t* rowp = base + (size_t)row * DM + col0;
#pragma unroll
                for (int bj = 0; bj < 2; ++bj) { float v[8];
#pragma unroll
                    for (int e = 0; e < 4; ++e) { v[e] = acc[ai][bj][m][0][e] * rs; v[4 + e] = acc[ai][bj][m][1][e] * rs; }
#pragma unroll
                    for (int e = 0; e < 8; ++e) { const float x = v[e]; const float sg = sigm(x * (kz0 + kz1 * x * x)); v[e] = x * (ka + kb * sg) + kc * sg; }
                    u32x4 w; w.x = pkbf(v[0], v[1]); w.y = pkbf(v[2], v[3]); w.z = pkbf(v[4], v[5]); w.w = pkbf(v[6], v[7]);
                    *(u32x4*)(rowp + bj * 128) = w; } }
    }
};
struct EpiSw {
    static constexpr bool PERM = true, AFTER_DRAIN = false;
    bf16_t* GVT; bf16_t* VT; const float* xsq; float* vsq;
    __device__ __forceinline__ void operator()(const f32x4 (&acc)[2][2][4][2], const pg8::Unit& u, int wr, int wc, int fr, int fq) const {
        asm volatile("" : "+v"(fr), "+v"(fq));
        const int colbase = u.pn * 256 + wc * 32 + 8 * fq;
        float cs[2][8];
#pragma unroll
        for (int bj = 0; bj < 2; ++bj)
#pragma unroll
            for (int e = 0; e < 8; ++e) cs[bj][e] = rs_of(xsq[pi_inv(colbase + bj * 128 + e)]);
        const bool isv = u.pm >= 4;
        bf16_t* out = isv ? VT + (size_t)((u.pm - 4) * 256) * M_TOK : GVT + (size_t)(u.pm * 256) * M_TOK;
        const int row0 = wr * 64 + fr;
        float ss[2][8];
#pragma unroll
        for (int bj = 0; bj < 2; ++bj)
#pragma unroll
            for (int e = 0; e < 8; ++e) ss[bj][e] = 0.f;
#pragma unroll
        for (int ai = 0; ai < 2; ++ai)
#pragma unroll
            for (int m = 0; m < 4; ++m) { bf16_t* rowp = out + (size_t)(row0 + ai * 128 + m * 16) * M_TOK + colbase;
#pragma unroll
                for (int bj = 0; bj < 2; ++bj) { float v[8];
#pragma unroll
                    for (int e = 0; e < 4; ++e) { v[e] = acc[ai][bj][m][0][e] * cs[bj][e]; v[4 + e] = acc[ai][bj][m][1][e] * cs[bj][4 + e]; }
                    if (!isv) {
#pragma unroll
                        for (int e = 0; e < 8; ++e) { v[e] = gelu_t(v[e]); ss[bj][e] += v[e] * v[e]; } }
                    u32x4 w; w.x = pkbf(v[0], v[1]); w.y = pkbf(v[2], v[3]); w.z = pkbf(v[4], v[5]); w.w = pkbf(v[6], v[7]);
                    *(u32x4*)(rowp + bj * 128) = w; } }
        if (!isv) {
            float mine = 0.f;
#pragma unroll
            for (int bj = 0; bj < 2; ++bj)
#pragma unroll
                for (int e = 0; e < 8; ++e) { float s = ss[bj][e];
                    s += __shfl_xor(s, 1); s += __shfl_xor(s, 2); s += __shfl_xor(s, 4); s += __shfl_xor(s, 8);
                    if (fr == bj * 8 + e) mine = s; }
            atomicAdd(vsq + colbase + (fr >> 3) * 128 + (fr & 7), mine);
        }
    }
};
struct EpiT {
    static constexpr bool PERM = true, AFTER_DRAIN = false;
    const bf16_t* GA; float* T;
    __device__ __forceinline__ void operator()(const f32x4 (&acc)[2][2][4][2], const pg8::Unit& u, int wr, int wc, int fr, int fq) const {
        asm volatile("" : "+v"(fr), "+v"(fq));
        const int col0 = u.pn * 256 + wc * 32 + 8 * fq, row0 = u.pm * 256 + wr * 64 + fr;
#pragma unroll
        for (int ai = 0; ai < 2; ++ai)
#pragma unroll
            for (int m = 0; m < 4; ++m)
#pragma unroll
                for (int bj = 0; bj < 2; ++bj) { const size_t off = (size_t)(row0 + ai * 128 + m * 16) * DM + col0 + bj * 128;
                    const u32x4 g = *(const u32x4*)(GA + off);
                    f32x4 a, b; a[0] = bflo(g.x); a[1] = bfhi(g.x); a[2] = bflo(g.y); a[3] = bfhi(g.y); b[0] = bflo(g.z); b[1] = bfhi(g.z); b[2] = bflo(g.w); b[3] = bfhi(g.w);
                    *(f32x4*)(T + off) = a * acc[ai][bj][m][0]; *(f32x4*)(T + off + 4) = b * acc[ai][bj][m][1]; }
    }
};
struct EpiMerge {
    static constexpr bool PERM = true, AFTER_DRAIN = false;
    const bf16_t* GB; const float* T; bf16_t* MG;
    __device__ __forceinline__ void operator()(const f32x4 (&acc)[2][2][4][2], const pg8::Unit& u, int wr, int wc, int fr, int fq) const {
        asm volatile("" : "+v"(fr), "+v"(fq));
        const int col0 = u.pn * 256 + wc * 32 + 8 * fq, row0 = u.pm * 256 + wr * 64 + fr;
#pragma unroll
        for (int ai = 0; ai < 2; ++ai)
#pragma unroll
            for (int m = 0; m < 4; ++m)
#pragma unroll
                for (int bj = 0; bj < 2; ++bj) { const size_t off = (size_t)(row0 + ai * 128 + m * 16) * DM + col0 + bj * 128;
                    const u32x4 g = *(const u32x4*)(GB + off);
                    f32x4 a, b; a[0] = bflo(g.x); a[1] = bfhi(g.x); a[2] = bflo(g.y); a[3] = bfhi(g.y); b[0] = bflo(g.z); b[1] = bfhi(g.z); b[2] = bflo(g.w); b[3] = bfhi(g.w);
                    const f32x4 r0 = *(const f32x4*)(T + off) + a * acc[ai][bj][m][0], r1 = *(const f32x4*)(T + off + 4) + b * acc[ai][bj][m][1];
                    u32x4 w; w.x = pkbf(r0[0], r0[1]); w.y = pkbf(r0[2], r0[3]); w.z = pkbf(r1[0], r1[1]); w.w = pkbf(r1[2], r1[3]);
                    *(u32x4*)(MG + off) = w; }
    }
};
struct EpiOut {
    static constexpr bool PERM = true, AFTER_DRAIN = false;
    const float* xin; float* xout; bf16_t* xb; bf16_t* xbp; float* xsq_next;
    __device__ __forceinline__ void operator()(const f32x4 (&acc)[2][2][4][2], const pg8::Unit& u, int wr, int wc, int fr, int fq) const {
        asm volatile("" : "+v"(fr), "+v"(fq));
        const int col0 = u.pn * 256 + wc * 32 + 8 * fq, row0 = u.pm * 256 + wr * 64 + fr;
#pragma unroll
        for (int ai = 0; ai < 2; ++ai)
#pragma unroll
            for (int m = 0; m < 4; ++m) { const int row = row0 + ai * 128 + m * 16, prow = pi_row(row); float ss = 0.f;
#pragma unroll
                for (int bj = 0; bj < 2; ++bj) { const size_t off = (size_t)row * DM + col0 + bj * 128;
                    const f32x4 r0 = *(const f32x4*)(xin + off) + acc[ai][bj][m][0], r1 = *(const f32x4*)(xin + off + 4) + acc[ai][bj][m][1];
                    *(f32x4*)(xout + off) = r0; *(f32x4*)(xout + off + 4) = r1;
                    ss += (r0[0] * r0[0] + r0[1] * r0[1]) + (r0[2] * r0[2] + r0[3] * r0[3]) + (r1[0] * r1[0] + r1[1] * r1[1]) + (r1[2] * r1[2] + r1[3] * r1[3]);
                    u32x4 w; w.x = pkbf(r0[0], r0[1]); w.y = pkbf(r0[2], r0[3]); w.z = pkbf(r1[0], r1[1]); w.w = pkbf(r1[2], r1[3]);
                    *(u32x4*)(xb + off) = w; *(u32x4*)(xbp + (size_t)prow * DM + col0 + bj * 128) = w; }
                ss += __shfl_xor(ss, 16); ss += __shfl_xor(ss, 32);
                if (fq == 0) atomicAdd(xsq_next + row, ss); }
    }
};
struct MixP { const bf16_t* WM; const bf16_t* GVT; const bf16_t* VT; const bf16_t* K; bf16_t* U; bf16_t* Q; const bf16_t* AG; const bf16_t* BG; const float* vsq; const float* b_s; const float* g_v; };
#define MFMA16(a, b, c) __builtin_amdgcn_mfma_f32_16x16x32_bf16((a), (b), (c), 0, 0, 0)

__device__ __forceinline__ void gating_item(const MixP& p, int layer, int it, int lane) {
    const int tt = it & 7, g = (it >> 3) & 7, c = (it >> 6) & 15, b = it >> 10;
    const int j = lane & 15, kg = lane >> 4;
    const bf16_t* wm = p.WM + ((size_t)((layer * 8 + g) * 128 + 16 * tt + j)) * 128 + 8 * kg;
    const bf16_t* ga = p.GVT + (size_t)(g * 128 + j) * M_TOK;
    f32x4 acc[8];
#pragma unroll
    for (int dt = 0; dt < 8; ++dt) acc[dt] = (f32x4){0.f, 0.f, 0.f, 0.f};
#pragma unroll
    for (int ks = 0; ks < 4; ++ks) {
        const int pb = b * 2048 + ks * 512 + 32 * c + 8 * kg;
        const u32x4 wraw = *(const u32x4*)(wm + 32 * ks);
        const f32x4 q0 = *(const f32x4*)(p.vsq + pb), q1 = *(const f32x4*)(p.vsq + pb + 4);
        u32x4 bw;
        bw.x = pkbf(bflo(wraw.x) * rs_of(q0[0]), bfhi(wraw.x) * rs_of(q0[1])); bw.y = pkbf(bflo(wraw.y) * rs_of(q0[2]), bfhi(wraw.y) * rs_of(q0[3]));
        bw.z = pkbf(bflo(wraw.z) * rs_of(q1[0]), bfhi(wraw.z) * rs_of(q1[1])); bw.w = pkbf(bflo(wraw.w) * rs_of(q1[2]), bfhi(wraw.w) * rs_of(q1[3]));
        const bf16x8 bfrag = __builtin_bit_cast(bf16x8, bw);
#pragma unroll
        for (int dt = 0; dt < 8; ++dt) { const bf16x8 afrag = *(const bf16x8*)(ga + (size_t)(16 * dt) * M_TOK + pb); acc[dt] = MFMA16(afrag, bfrag, acc[dt]); }
    }
    const int t = 16 * tt + j; const size_t token = (size_t)b * 2048 + 128 * c + t;
    const float bias = p.b_s[(layer * 8 + g) * 128 + t];
#pragma unroll
    for (int dt = 0; dt < 8; ++dt) { const int d4 = g * 128 + 16 * dt + 4 * kg; const size_t off = token * DM + d4;
        const f32x4 gv = *(const f32x4*)(p.g_v + layer * 1024 + d4);
        const u32x2 u2 = *(const u32x2*)(p.U + off), a2 = *(const u32x2*)(p.AG + off);
        const float y0 = bflo(u2.x) * (acc[dt][0] * gv[0] + bias) * bflo(a2.x), y1 = bfhi(u2.x) * (acc[dt][1] * gv[1] + bias) * bfhi(a2.x);
        const float y2 = bflo(u2.y) * (acc[dt][2] * gv[2] + bias) * bflo(a2.y), y3 = bfhi(u2.y) * (acc[dt][3] * gv[3] + bias) * bfhi(a2.y);
        u32x2 w; w.x = pkbf(y0, y1); w.y = pkbf(y2, y3); *(u32x2*)(p.U + off) = w; }
}

__device__ __forceinline__ void attn_step(const bf16_t* Kh, const bf16_t* Vh, int sc, int rp, int dbase, float slope2, int j,
                                          const bf16x8 (&qf)[2][2], f32x4 (&o)[2][4], float (&m)[2], float (&l)[2]) {
    bf16x8 kf[2][2], vf[4];
#pragma unroll
    for (int a = 0; a < 2; ++a) { const int n = 8 * (j >> 2) + 4 * a + (j & 3); const size_t tk = (size_t)(128 * sc + rp + 4 * n);
#pragma unroll
        for (int ks = 0; ks < 2; ++ks) kf[a][ks] = *(const bf16x8*)(Kh + tk * DM + 32 * ks); }
#pragma unroll
    for (int dt = 0; dt < 4; ++dt) vf[dt] = *(const bf16x8*)(Vh + (size_t)(16 * dt) * M_TOK + rp * 512 + 32 * sc);
    bf16x8 pf[2];
#pragma unroll
    for (int qt = 0; qt < 2; ++qt) {
        f32x4 s[2];
#pragma unroll
        for (int a = 0; a < 2; ++a) { s[a] = MFMA16(kf[a][0], qf[qt][0], ((f32x4){0.f, 0.f, 0.f, 0.f})); s[a] = MFMA16(kf[a][1], qf[qt][1], s[a]); }
        const int base = dbase + 64 * qt;
        float sv[8]; float mx = -1e30f;
#pragma unroll
        for (int a = 0; a < 2; ++a)
#pragma unroll
            for (int r = 0; r < 4; ++r) { const int dlt = base - 16 * a - 4 * r;
                const int c = (int)(dlt <= 128) + (int)(((dlt & 3) == 0) & (dlt <= 512)) + (int)((dlt & 15) == 0);
                const float lg = c == 3 ? 1.5849625007f : (c == 2 ? 1.f : 0.f);
                float x = s[a][r] - slope2 * (float)dlt + lg;
                x = (dlt >= 0 && c > 0) ? x : -INFINITY;
                sv[4 * a + r] = x; mx = fmaxf(mx, x); }
        mx = fmaxf(mx, __shfl_xor(mx, 16)); mx = fmaxf(mx, __shfl_xor(mx, 32));
        const float mnew = fmaxf(m[qt], mx), alpha = __builtin_amdgcn_exp2f(m[qt] - mnew); m[qt] = mnew;
        float ps = 0.f;
#pragma unroll
        for (int e = 0; e < 8; ++e) { sv[e] = __builtin_amdgcn_exp2f(sv[e] - mnew); ps += sv[e]; }
        l[qt] = l[qt] * alpha + ps;
#pragma unroll
        for (int dt = 0; dt < 4; ++dt) o[qt][dt] = o[qt][dt] * alpha;
        u32x4 pw; pw.x = pkbf(sv[0], sv[1]); pw.y = pkbf(sv[2], sv[3]); pw.z = pkbf(sv[4], sv[5]); pw.w = pkbf(sv[6], sv[7]);
        pf[qt] = __builtin_bit_cast(bf16x8, pw);
    }
#pragma unroll
    for (int dt = 0; dt < 4; ++dt)
#pragma unroll
        for (int qt = 0; qt < 2; ++qt) o[qt][dt] = MFMA16(vf[dt], pf[qt], o[qt][dt]);
}
__device__ __forceinline__ void attn_item(const MixP& p, int b, int h, int nb, int rho, int lane) {
    const int j = lane & 15, kg = lane >> 4; const size_t rowb = (size_t)b * 2048;
    const bf16_t* Kh = p.K + rowb * DM + h * 64 + 8 * kg;
    const bf16_t* Vh = p.VT + (size_t)(h * 64 + j) * M_TOK + rowb + 8 * kg;
    bf16x8 qf[2][2];
#pragma unroll
    for (int qt = 0; qt < 2; ++qt) { const size_t tq = rowb + 128 * nb + 64 * qt + rho + 4 * j;
#pragma unroll
        for (int ks = 0; ks < 2; ++ks) qf[qt][ks] = *(const bf16x8*)(p.Q + tq * DM + h * 64 + 32 * ks + 8 * kg); }
    f32x4 o[2][4]; float m[2] = {-1e30f, -1e30f}, l[2] = {0.f, 0.f};
#pragma unroll
    for (int qt = 0; qt < 2; ++qt)
#pragma unroll
        for (int dt = 0; dt < 4; ++dt) o[qt][dt] = (f32x4){0.f, 0.f, 0.f, 0.f};
    const float slope2 = __builtin_amdgcn_exp2f(-0.5f * (float)(h + 1)) * LOG2E;
    const int lb = 4 * j - 32 * kg;
    for (int sc = 0; sc <= nb; ++sc) attn_step(Kh, Vh, sc, rho, 128 * (nb - sc) + lb, slope2, j, qf, o, m, l);
    for (int sc = (nb > 0 ? nb - 1 : 0); sc <= nb; ++sc)
        for (int d = 1; d < 4; ++d) { const int rp = (rho + d) & 3; attn_step(Kh, Vh, sc, rp, 128 * (nb - sc) + (rho - rp) + lb, slope2, j, qf, o, m, l); }
#pragma unroll
    for (int qt = 0; qt < 2; ++qt) { float lt = l[qt]; lt += __shfl_xor(lt, 16); lt += __shfl_xor(lt, 32); const float inv = 1.0f / lt;
        const size_t tq = rowb + 128 * nb + 64 * qt + rho + 4 * j;
#pragma unroll
        for (int dt = 0; dt < 4; ++dt) { const size_t off = tq * DM + h * 64 + 16 * dt + 4 * kg;
            const u32x2 g2 = *(const u32x2*)(p.BG + off);
            u32x2 w; w.x = pkbf(o[qt][dt][0] * inv * bflo(g2.x), o[qt][dt][1] * inv * bfhi(g2.x)); w.y = pkbf(o[qt][dt][2] * inv * bflo(g2.y), o[qt][dt][3] * inv * bfhi(g2.y));
            *(u32x2*)(p.Q + off) = w; } }
}

__device__ __forceinline__ float wave_sum(float v) {
#pragma unroll
    for (int o = 1; o < 64; o <<= 1) v += __shfl_xor(v, o);
    return v;
}
__device__ __forceinline__ void tr_tile(const float* W, int N, int k0, int n0, const float* gk, bf16_t* dst, int K, LAS float* scr, int lane) {
#pragma unroll 8
    for (int i = 0; i < 32; ++i) { const int kk = 2 * i + (lane >> 5); float v = W[(size_t)(k0 + kk) * N + n0 + (lane & 31)]; if (gk) v *= gk[k0 + kk]; scr[kk * 33 + (lane & 31)] = v; }
    asm volatile("s_waitcnt lgkmcnt(0)" ::: "memory");
    const int c = lane & 7;
#pragma unroll
    for (int jj = 0; jj < 4; ++jj) { const int n = (lane >> 3) + 8 * jj; const LAS float* s = scr + (8 * c) * 33 + n;
        u32x4 o; o.x = pkbf(s[0 * 33], s[1 * 33]); o.y = pkbf(s[2 * 33], s[3 * 33]); o.z = pkbf(s[4 * 33], s[5 * 33]); o.w = pkbf(s[6 * 33], s[7 * 33]);
        *(u32x4*)(dst + (size_t)n * K + k0 + 8 * c) = o; }
    asm volatile("s_waitcnt lgkmcnt(0)" ::: "memory");
}

struct Args { const float* in[10]; float* out; unsigned char* ws; int ph_lo, ph_hi; };
constexpr int N_PHASES = 2 + 4 * DEPTH;

__global__ void __launch_bounds__(NWAVES * 64, 2) hyb_fwd(Args args) {
    extern __shared__ __attribute__((aligned(16))) unsigned char lds[];
    LAS unsigned char* L = (LAS unsigned char*)lds;
    const int tid = threadIdx.x, lane = tid & 63, wave = __builtin_amdgcn_readfirstlane(tid >> 6);
    const int G = gridDim.x, bx = blockIdx.x, vcu = (G % 8 == 0) ? (bx % 8) * (G / 8) + bx / 8 : bx;
    const int gw = vcu * NWAVES + wave, NGW = G * NWAVES;
    const float* x_in = args.in[0]; const float* g_norm = args.in[1]; const float* w_in = args.in[2]; const float* w_s = args.in[3]; const float* b_s = args.in[4];
    const float* g_v = args.in[5]; const float* w_pa = args.in[6]; const float* w_pb = args.in[7]; const float* w_out = args.in[8]; const float* g_final = args.in[9];
#define WS_PTRS() unsigned char* ws = args.ws; asm volatile("" : "+s"(ws)); \
    float* xsq = (float*)(ws + WS_XSQ); float* vsq = (float*)(ws + WS_VSQ); \
    bf16_t* WM = (bf16_t*)(ws + WS_WM); bf16_t* WTM = (bf16_t*)(ws + WS_WT_MAIN); bf16_t* WTS = (bf16_t*)(ws + WS_WT_SW); \
    bf16_t* WTA = (bf16_t*)(ws + WS_WT_A); bf16_t* WTB = (bf16_t*)(ws + WS_WT_B); bf16_t* WTO = (bf16_t*)(ws + WS_WT_O); \
    bf16_t* XB = (bf16_t*)(ws + WS_XB); bf16_t* XBP = (bf16_t*)(ws + WS_XBP); bf16_t* ACT = (bf16_t*)(ws + WS_ACT); \
    bf16_t* GVT = (bf16_t*)(ws + WS_GVT); bf16_t* VT = (bf16_t*)(ws + WS_VT); float* T = (float*)(ws + WS_T); bf16_t* MG = (bf16_t*)(ws + WS_MG); \
    bf16_t* bU = ACT; bf16_t* bAG = ACT + ACT_STRIDE; bf16_t* bQ = ACT + 2 * ACT_STRIDE; bf16_t* bK = ACT + 3 * ACT_STRIDE; bf16_t* bBG = ACT + 4 * ACT_STRIDE; \
    bf16_t* bGA = ACT + 5 * ACT_STRIDE; bf16_t* bGB = ACT + 6 * ACT_STRIDE; \
    (void)xsq; (void)vsq; (void)WM; (void)WTM; (void)WTS; (void)WTA; (void)WTB; (void)WTO; (void)XB; (void)XBP; (void)GVT; (void)VT; (void)T; (void)MG; \
    (void)bU; (void)bAG; (void)bQ; (void)bK; (void)bBG; (void)bGA; (void)bGB
    const int lo = args.ph_lo, hi = args.ph_hi;
#define IN(k) (lo <= (k) && (k) < hi)
#define SEAM(k) do { if (IN(k) && IN((k) + 1)) { __threadfence(); cg::this_grid().sync(); } } while (0)

    if (IN(0)) {
        WS_PTRS();
        LAS float* scr = (LAS float*)(L + wave * 16384);
        constexpr int T_IN = 16 * 288, T_SQ = 16 * 32;
        for (int it = gw; it < DEPTH * (T_IN + 3 * T_SQ); it += NGW) {
            if (it < DEPTH * T_IN) {
                const int l = it / T_IN, r = it % T_IN, kb = r / 288, nbk = r % 288, n0 = 32 * nbk;
                bf16_t* dst;
                if (n0 < 1024) dst = WTM + ((size_t)l * N_MAIN + n0) * DM;
                else if (n0 < 2048) dst = WTS + ((size_t)l * N_SW + (n0 - 1024)) * DM;
                else if (n0 < 5120) dst = WTM + ((size_t)l * N_MAIN + (n0 - 1024)) * DM;
                else if (n0 < 6144) dst = WTS + ((size_t)l * N_SW + 1024 + (n0 - 5120)) * DM;
                else dst = WTM + ((size_t)l * N_MAIN + (n0 - 2048)) * DM;
                tr_tile(w_in + (size_t)l * DM * IN_COLS, IN_COLS, 64 * kb, n0, g_norm + l * DM, dst, DM, scr, lane);
            } else {
                const int r0 = it - DEPTH * T_IN, which = r0 / (DEPTH * T_SQ), r1 = r0 % (DEPTH * T_SQ), l = r1 / T_SQ, r = r1 % T_SQ, kb = r / 32, nbk = r % 32;
                const float* W = (which == 0 ? w_pa : which == 1 ? w_pb : w_out) + (size_t)l * DM * DM;
                bf16_t* dst = (which == 0 ? WTA : which == 1 ? WTB : WTO) + ((size_t)l * DM + 32 * nbk) * DM;
                tr_tile(W, DM, 64 * kb, 32 * nbk, nullptr, dst, DM, scr, lane);
            }
        }
        for (int mrow = gw; mrow < M_TOK; mrow += NGW) {
            const f32x4* xr = (const f32x4*)(x_in + (size_t)mrow * DM) + lane; f32x4 v[4]; float s = 0.f;
#pragma unroll
            for (int q = 0; q < 4; ++q) { v[q] = xr[64 * q]; s += (v[q][0] * v[q][0] + v[q][1] * v[q][1]) + (v[q][2] * v[q][2] + v[q][3] * v[q][3]); }
            s = wave_sum(s);
            u32x2* o1 = (u32x2*)(XB + (size_t)mrow * DM) + lane; u32x2* o2 = (u32x2*)(XBP + (size_t)pi_row(mrow) * DM) + lane;
#pragma unroll
            for (int q = 0; q < 4; ++q) { u32x2 w; w.x = pkbf(v[q][0], v[q][1]); w.y = pkbf(v[q][2], v[q][3]); o1[64 * q] = w; o2[64 * q] = w; }
            if (lane == 0) xsq[mrow] = s;
        }
        const int gt = vcu * (NWAVES * 64) + tid, NGT = G * NWAVES * 64;
        for (int i = gt; i < 4 * M_TOK; i += NGT) { xsq[M_TOK + i] = 0.f; vsq[i] = 0.f; }
        for (int i = gt; i < DEPTH * 8 * 128 * 128; i += NGT) { const int sg = i & 127, t = (i >> 7) & 127, s = (sg & 31) * 4 + (sg >> 5);
            const float v = (s <= t) ? w_s[(size_t)(i >> 14) * 16384 + t * 128 + s] : 0.f; WM[i] = (bf16_t)(pkbf(v, 0.f) & 0xffffu); }
    }
    SEAM(0);

    for (int layer = 0; layer < DEPTH; ++layer) {
        const int ph = 1 + 4 * layer;
        if (IN(ph)) {
            WS_PTRS();
            { pg8::Gemm g{XB, WTM + (size_t)layer * N_MAIN * DM, M_TOK, N_MAIN, DM}; pg8::StaticOrder S; S.init(M_TOK, N_MAIN, G, bx);
              EpiMain E{ACT, xsq + layer * M_TOK};
              pg8::gemm_phase<EpiMain, pg8::StaticOrder, true, true>(L, g, S, E); }
            { pg8::Gemm g{WTS + (size_t)layer * N_SW * DM, XBP, N_SW, M_TOK, DM}; pg8::StaticOrder S; S.init(N_SW, M_TOK, G, bx);
              EpiSw E{GVT, VT, xsq + layer * M_TOK, vsq + layer * M_TOK};
              pg8::gemm_phase<EpiSw, pg8::StaticOrder, true, true>(L, g, S, E); }
        }
        SEAM(ph);
        if (IN(ph + 1)) {
            WS_PTRS(); int ln = lane; asm volatile("" : "+v"(ln));
            MixP p{WM, GVT, VT, bK, bU, bQ, bAG, bBG, vsq + layer * M_TOK, b_s, g_v};
            for (int it = gw; it < 8192; it += NGW) gating_item(p, layer, it, ln);
            for (int pr = gw; pr < 4096; pr += NGW) { const int rho = pr & 3, s = (pr >> 2) & 7, bh = pr >> 5;
                attn_item(p, bh >> 4, bh & 15, s, rho, ln); attn_item(p, bh >> 4, bh & 15, 15 - s, rho, ln); }
        }
        SEAM(ph + 1);
        if (IN(ph + 2)) {
            WS_PTRS();
            { pg8::Gemm g{bU, WTA + (size_t)layer * DM * DM, M_TOK, DM, DM}; pg8::StaticOrder S; S.init(M_TOK, DM, G, bx);
              EpiT E{bGA, T}; pg8::gemm_phase<EpiT, pg8::StaticOrder, true, true>(L, g, S, E); }
            { pg8::Gemm g{bQ, WTB + (size_t)layer * DM * DM, M_TOK, DM, DM}; pg8::StaticOrder S; S.init(M_TOK, DM, G, bx);
              EpiMerge E{bGB, T, MG}; pg8::gemm_phase<EpiMerge, pg8::StaticOrder, true, true>(L, g, S, E); }
        }
        SEAM(ph + 2);
        if (IN(ph + 3)) {
            WS_PTRS();
            pg8::Gemm g{MG, WTO + (size_t)layer * DM * DM, M_TOK, DM, DM}; pg8::StaticOrder S; S.init(M_TOK, DM, G, bx);
            EpiOut E{layer == 0 ? x_in : args.out, args.out, XB, XBP, xsq + (layer + 1) * M_TOK};
            pg8::gemm_phase<EpiOut, pg8::StaticOrder, true, true>(L, g, S, E);
        }
        SEAM(ph + 3);
    }
    if (IN(N_PHASES - 1)) {
        WS_PTRS();
        const float* fs = xsq + DEPTH * M_TOK;
        for (int mrow = gw; mrow < M_TOK; mrow += NGW) { const float rs = rs_of(fs[mrow]); f32x4* xr = (f32x4*)(args.out + (size_t)mrow * DM) + lane;
#pragma unroll
            for (int q = 0; q < 4; ++q) { const f32x4 gq = *((const f32x4*)g_final + lane + 64 * q); xr[64 * q] = xr[64 * q] * rs * gq; } }
    }
#undef IN
#undef SEAM
#undef WS_PTRS
}


#ifndef NAIVE_MASK
#define NAIVE_MASK 0
#endif
__global__ void naive_inproj(const float* xres, const float* g_norm_l, const float* w_in_l, const float* xsq_l, bf16_t* ACT, bf16_t* GVT, bf16_t* VT, float* vsq_l, int colmask) {
    const int m = blockIdx.y, n = blockIdx.x * 256 + threadIdx.x;
    { const bool sw = (n >= 1024 && n < 2048) || (n >= 5120 && n < 6144); if (sw) { if (!((colmask >> 1) & 1)) return; }
      else { const int sg = n < 1024 ? 0 : n < 3072 ? 1 : n < 4096 ? 2 : n < 5120 ? 3 : n < 7168 ? 4 : n < 8192 ? 5 : 6; if (!((colmask >> (8 + sg)) & 1)) return; } }
    const float* xr = xres + (size_t)m * DM; float acc = 0.f;
    for (int k = 0; k < DM; ++k) acc += xr[k] * g_norm_l[k] * w_in_l[(size_t)k * IN_COLS + n];
    const float v = acc * rs_of(xsq_l[m]);
    const int pm_ = pi_row(m);
    if (n < 1024) ACT[0 * ACT_STRIDE + (size_t)m * DM + n] = (bf16_t)(pkbf(gelu_t(v), 0.f) & 0xffffu);
    else if (n < 2048) { const float g = gelu_t(v); GVT[(size_t)(n - 1024) * M_TOK + pm_] = (bf16_t)(pkbf(g, 0.f) & 0xffffu); atomicAdd(vsq_l + pm_, g * g); }
    else if (n < 3072) ACT[1 * ACT_STRIDE + (size_t)m * DM + (n - 2048)] = (bf16_t)(pkbf(v * sigm(v), 0.f) & 0xffffu);
    else if (n < 4096) ACT[2 * ACT_STRIDE + (size_t)m * DM + (n - 3072)] = (bf16_t)(pkbf(v * QSCALE, 0.f) & 0xffffu);
    else if (n < 5120) ACT[3 * ACT_STRIDE + (size_t)m * DM + (n - 4096)] = (bf16_t)(pkbf(v, 0.f) & 0xffffu);
    else if (n < 6144) VT[(size_t)(n - 5120) * M_TOK + pm_] = (bf16_t)(pkbf(v, 0.f) & 0xffffu);
    else if (n < 7168) ACT[4 * ACT_STRIDE + (size_t)m * DM + (n - 6144)] = (bf16_t)(pkbf(v * sigm(v), 0.f) & 0xffffu);
    else if (n < 8192) ACT[5 * ACT_STRIDE + (size_t)m * DM + (n - 7168)] = (bf16_t)(pkbf(sigm(v), 0.f) & 0xffffu);
    else ACT[6 * ACT_STRIDE + (size_t)m * DM + (n - 8192)] = (bf16_t)(pkbf(sigm(v), 0.f) & 0xffffu);
}
__global__ void naive_merge(const bf16_t* YA, const bf16_t* YB, const float* wa, const float* wb, const bf16_t* GA, const bf16_t* GB, bf16_t* MG) {
    const int m = blockIdx.y, n = blockIdx.x * 256 + threadIdx.x; float a = 0.f, b = 0.f;
    for (int k = 0; k < DM; ++k) { a += bf2f(YA[(size_t)m * DM + k]) * wa[(size_t)k * DM + n]; b += bf2f(YB[(size_t)m * DM + k]) * wb[(size_t)k * DM + n]; }
    const size_t o = (size_t)m * DM + n;
    MG[o] = (bf16_t)(pkbf(bf2f(GA[o]) * a + bf2f(GB[o]) * b, 0.f) & 0xffffu);
}
__global__ void naive_out(const bf16_t* MG, const float* wo, const float* xin, float* xout, bf16_t* XB, bf16_t* XBP, float* xsq_next) {
    const int m = blockIdx.y, n = blockIdx.x * 256 + threadIdx.x; float a = 0.f;
    for (int k = 0; k < DM; ++k) a += bf2f(MG[(size_t)m * DM + k]) * wo[(size_t)k * DM + n];
    const size_t o = (size_t)m * DM + n; const float r = xin[o] + a; xout[o] = r;
    const bf16_t h = (bf16_t)(pkbf(r, 0.f) & 0xffffu); XB[o] = h; XBP[(size_t)pi_row(m) * DM + n] = h; atomicAdd(xsq_next + m, r * r);
}

extern "C" void kernel_launch(void* const* d_in, const int* in_sizes, int n_in, void* d_out, int out_size, void* d_ws, size_t ws_size, hipStream_t stream) {
    static int grid = 0;
    if (grid == 0) {
        if (n_in != 10 || in_sizes[0] != M_TOK * DM || out_size != M_TOK * DM || ws_size < WS_END) { fprintf(stderr, "kernel_launch: unexpected shapes / workspace (%d inputs, ws %zu, need %zu)\n", n_in, ws_size, (size_t)WS_END); grid = -1; return; }
        int dev = 0, cus = 0, per_cu = 0;
        (void)hipGetDevice(&dev); (void)hipDeviceGetAttribute(&cus, hipDeviceAttributeMultiprocessorCount, dev);
        if (hipFuncSetAttribute((const void*)hyb_fwd, hipFuncAttributeMaxDynamicSharedMemorySize, LDS_BYTES) != hipSuccess) { fprintf(stderr, "kernel_launch: hipFuncSetAttribute failed\n"); grid = -1; return; }
        if (hipOccupancyMaxActiveBlocksPerMultiprocessor(&per_cu, (const void*)hyb_fwd, NWAVES * 64, LDS_BYTES) != hipSuccess || per_cu < 1) per_cu = 1;
        (void)hipGetLastError();
        if (cus <= 0) cus = 256;
        grid = cus * per_cu;
    }
    if (grid < 0) return;
    Args a{};
    for (int i = 0; i < 10; ++i) a.in[i] = (const float*)d_in[i];
    a.out = (float*)d_out; a.ws = (unsigned char*)d_ws;
#if MK_MULTI
    for (int ph = 0; ph < N_PHASES; ++ph) {
        unsigned char* ws = (unsigned char*)d_ws; const int layer = (ph - 1) / 4, sub = (ph - 1) % 4;
        float* xsq = (float*)(ws + WS_XSQ); float* vsq = (float*)(ws + WS_VSQ); bf16_t* ACT = (bf16_t*)(ws + WS_ACT);
        const float* xres = layer == 0 ? (const float*)d_in[0] : (const float*)d_out;
        if (ph >= 1 && ph < N_PHASES - 1 && sub == 0 && (NAIVE_MASK & 1)) {
            a.ph_lo = ph; a.ph_hi = ph + 1; hipLaunchKernelGGL(hyb_fwd, dim3(grid), dim3(NWAVES * 64), LDS_BYTES, stream, a);
            if (NAIVE_COLMASK & 2) hipMemsetAsync(vsq + layer * M_TOK, 0, M_TOK * 4, stream);
            hipLaunchKernelGGL(naive_inproj, dim3(IN_COLS / 256, M_TOK), dim3(256), 0, stream, xres, (const float*)d_in[1] + layer * DM, (const float*)d_in[2] + (size_t)layer * DM * IN_COLS,
                               xsq + layer * M_TOK, ACT, (bf16_t*)(ws + WS_GVT), (bf16_t*)(ws + WS_VT), vsq + layer * M_TOK, NAIVE_COLMASK);
        } else if (ph >= 1 && ph < N_PHASES - 1 && sub == 2 && (NAIVE_MASK & 2)) {
            hipLaunchKernelGGL(naive_merge, dim3(DM / 256, M_TOK), dim3(256), 0, stream, ACT, ACT + 2 * ACT_STRIDE, (const float*)d_in[6] + (size_t)layer * DM * DM, (const float*)d_in[7] + (size_t)layer * DM * DM,
                               ACT + 5 * ACT_STRIDE, ACT + 6 * ACT_STRIDE, (bf16_t*)(ws + WS_MG));
        } else if (ph >= 1 && ph < N_PHASES - 1 && sub == 3 && (NAIVE_MASK & 4)) {
            hipLaunchKernelGGL(naive_out, dim3(DM / 256, M_TOK), dim3(256), 0, stream, (const bf16_t*)(ws + WS_MG), (const float*)d_in[8] + (size_t)layer * DM * DM, xres, (float*)d_out,
                               (bf16_t*)(ws + WS_XB), (bf16_t*)(ws + WS_XBP), xsq + (layer + 1) * M_TOK);
        } else { a.ph_lo = ph; a.ph_hi = ph + 1; hipLaunchKernelGGL(hyb_fwd, dim3(grid), dim3(NWAVES * 64), LDS_BYTES, stream, a); }
    }
#else
    a.ph_lo = 0; a.ph_hi = N_PHASES;
    void* kargs[] = {&a};
    hipError_t e = hipLaunchCooperativeKernel((const void*)hyb_fwd, dim3(grid), dim3(NWAVES * 64), kargs, LDS_BYTES, stream);
    if (e != hipSuccess) fprintf(stderr, "kernel_launch: cooperative launch failed: %s (grid %d)\n", hipGetErrorString(e), grid);
#endif
}
```

```cpp
#include <hip/hip_runtime.h>
#include <hip/hip_cooperative_groups.h>
#include <cstdio>
#include <cstdint>
namespace cg = cooperative_groups;
#ifndef DUP
#define DUP 0
#endif
#ifndef MK_MULTI
#define MK_MULTI 0
#endif
namespace pg8 {
#define PG8_LAS __attribute__((address_space(3)))
typedef unsigned short bf16_t;
typedef short bf16x8 __attribute__((ext_vector_type(8)));
typedef float f32x4 __attribute__((ext_vector_type(4)));
typedef unsigned u32x4 __attribute__((ext_vector_type(4)));
constexpr int BM = 256, BK = 64, HALF = 128, HTB = HALF * BK * 2  , STAGE_BYTES = 8 * HTB, NXCD = 8, WGM = 8;

__host__ __device__ __forceinline__ int lds_byte(int r, int c) { const int st = (r >> 4) * 2 + (c >> 5), rr = r & 15, cc = c & 31, ob = rr * 64 + cc * 2; return st * 1024 + (ob ^ (((ob >> 9) & 1) << 5)); }
__host__ __device__ __forceinline__ void stage_rc(int b, int& R, int& C) { const int st = b / 1024, sb = b % 1024, swz = sb ^ (((sb >> 9) & 1) << 5); R = (st >> 1) * 16 + swz / 64; C = (st & 1) * 32 + (swz % 64) / 2; }
__host__ __device__ __forceinline__ int perm32(int rho) { const int n = rho >> 4, i = rho & 15; return 8 * (i >> 2) + 4 * n + (i & 3); }

struct Unit { int pm, pn; };
struct Gemm { const bf16_t* A; const bf16_t* Bt; int M, N, K; };

struct StaticOrder {
    int nM, nN, nwg, G, c;
    __host__ __device__ void init(int M, int N, int G_, int c_) { nM = M / BM; nN = N / BM; nwg = nM * nN; G = G_; c = c_; }
    __host__ __device__ bool next(int i, Unit& u) const {
        const long L = (long)i * G + c; if (L >= nwg) return false;
        int wgid = (int)L; { const int q = nwg / NXCD, r = nwg % NXCD, xcd = wgid % NXCD, off = wgid / NXCD; wgid = (xcd < r ? xcd * (q + 1) : r * (q + 1) + (xcd - r) * q) + off; }
        const int nig = WGM * nN, gid = wgid / nig, fm = gid * WGM, gsz = (nM - fm) < WGM ? (nM - fm) : WGM;
        u.pm = fm + ((wgid % nig) % gsz); u.pn = (wgid % nig) / gsz; return true;
    }
    __device__ __forceinline__ void a_ready(const Unit&) const {}
    __device__ __forceinline__ void done(const Unit&) const {}
};
__device__ __forceinline__ unsigned cvt_pk_bf16(float lo, float hi) { unsigned r; asm volatile("v_cvt_pk_bf16_f32 %0, %1, %2" : "=v"(r) : "v"(lo), "v"(hi)); return r; }
template <class Epi, class Sched, bool ALIGN_EPI = false, bool SP2 = false>
__device__ __forceinline__ void gemm_phase(PG8_LAS unsigned char* lds, const Gemm g, const Sched& S, const Epi& E) {
    int tid = threadIdx.x; asm volatile("" : "+v"(tid));
    const int wid = __builtin_amdgcn_readfirstlane(tid >> 6), lane = tid & 63, wr = wid >> 2, wc = wid & 3, fr = lane & 15, fq = lane >> 4;
    const int K = g.K, nt = K / BK;
    unsigned voffA[2], voffB[2];
#pragma unroll
    for (int i = 0; i < 2; ++i) { int R, C; stage_rc(tid * 16 + i * 8192, R, C); const int Rb = Epi::PERM ? ((R & ~31) + perm32(R & 31)) : R;
        voffA[i] = (unsigned)(R * K + C) * 2u; voffB[i] = (unsigned)(Rb * K + C) * 2u; }
    const size_t kstep = (size_t)(BK * 2);
    const size_t hstep = (size_t)HALF * K * 2;
    const size_t tstep = 2 * hstep;
    const unsigned ldsw = (unsigned)wid * 1024u;
    const int aoff = lds_byte(wr * 64 + fr, fq * 8), boff = lds_byte(wc * 32 + fr, fq * 8);
#define PG8_SA(b, h) (((b) * 2 + (h)) * HTB)
#define PG8_SB(b, h) ((4 + (b) * 2 + (h)) * HTB)
#define PG8_STAGE(bufoff, gbase, voff) do { _Pragma("unroll") for (int _i = 0; _i < 2; ++_i) \
        __builtin_amdgcn_global_load_lds((const unsigned*)((const char*)(gbase) + (voff)[_i]), (PG8_LAS unsigned*)(lds + (bufoff) + ldsw + _i * 8192), 16, 0, 0); } while (0)
#define PG8_LDA(dst, b, h) do { _Pragma("unroll") for (int m = 0; m < 4; ++m) _Pragma("unroll") for (int k = 0; k < 2; ++k) dst[m][k] = *(const PG8_LAS bf16x8*)(lds + PG8_SA(b, h) + aoff + m * 2048 + k * 1024); } while (0)
#define PG8_LDB(dst, b, h) do { _Pragma("unroll") for (int n = 0; n < 2; ++n) _Pragma("unroll") for (int k = 0; k < 2; ++k) dst[n][k] = *(const PG8_LAS bf16x8*)(lds + PG8_SB(b, h) + boff + n * 2048 + k * 1024); } while (0)
#define PG8_MMA(ai, bj, At, Bt) do { __builtin_amdgcn_s_setprio(1); _Pragma("unroll") for (int m = 0; m < 4; ++m) _Pragma("unroll") for (int n = 0; n < 2; ++n) _Pragma("unroll") for (int k = 0; k < 2; ++k) \
        acc[ai][bj][m][n] = __builtin_amdgcn_mfma_f32_16x16x32_bf16(Bt[n][k], At[m][k], acc[ai][bj][m][n], 0, 0, 0); __builtin_amdgcn_s_setprio(0); } while (0)
#define PG8_WAIT_V(n) asm volatile("s_waitcnt vmcnt(" #n ")" ::: "memory")
#define PG8_WAIT_L(n) asm volatile("s_waitcnt lgkmcnt(" #n ")" ::: "memory")
#define PG8_BAR __builtin_amdgcn_s_barrier()
#define PG8_SCHED __builtin_amdgcn_sched_barrier(0)
    Unit cur, nxt; int ui = 0;
    if (!S.next(0, cur)) return;
    f32x4 acc[2][2][4][2];
#pragma unroll
    for (int a = 0; a < 2; ++a)
#pragma unroll
        for (int b = 0; b < 2; ++b)
#pragma unroll
            for (int m = 0; m < 4; ++m)
#pragma unroll
                for (int n = 0; n < 2; ++n) acc[a][b][m][n] = (f32x4){0.f, 0.f, 0.f, 0.f};
    bf16x8 At[4][2], B0[2][2], B1[2][2];
    const char* cA = (const char*)g.A + (size_t)cur.pm * tstep; const char* cB = (const char*)g.Bt + (size_t)cur.pn * tstep;
    S.a_ready(cur);
    if constexpr (SP2) {
        PG8_STAGE(PG8_SB(0, 0), cB, voffB); PG8_STAGE(PG8_SB(0, 1), cB + hstep, voffB); PG8_STAGE(PG8_SA(0, 0), cA, voffA); PG8_STAGE(PG8_SA(0, 1), cA + hstep, voffA);
        if (wr == 1) PG8_BAR;
        PG8_WAIT_V(2); PG8_BAR;
        PG8_STAGE(PG8_SB(1, 0), cB + kstep, voffB); PG8_STAGE(PG8_SA(1, 0), cA + kstep, voffA); PG8_STAGE(PG8_SB(1, 1), cB + hstep + kstep, voffB);
        PG8_WAIT_V(6); PG8_BAR;
    } else {
        PG8_STAGE(PG8_SB(0, 0), cB, voffB); PG8_STAGE(PG8_SA(0, 0), cA, voffA); PG8_STAGE(PG8_SB(0, 1), cB + hstep, voffB); PG8_STAGE(PG8_SA(0, 1), cA + hstep, voffA);
        if (wr == 1) PG8_BAR;
        PG8_WAIT_V(4); PG8_BAR;
        PG8_STAGE(PG8_SB(1, 0), cB + kstep, voffB); PG8_STAGE(PG8_SA(1, 0), cA + kstep, voffA); PG8_STAGE(PG8_SB(1, 1), cB + hstep + kstep, voffB);
        PG8_WAIT_V(6); PG8_BAR;
    }
    for (;;) {
        const bool has_next = S.next(ui + 1, nxt);
        const char* nA = has_next ? (const char*)g.A + (size_t)nxt.pm * tstep : cA; const char* nB = has_next ? (const char*)g.Bt + (size_t)nxt.pn * tstep : cB;
        for (int t = 0; t < nt; t += 2) {
            if constexpr (Epi::MIDK) { if (t == nt / 2) E.mid(acc, cur, wr, wc, fr, fq); }
            const bool last = (t == nt - 2);
            const char* a1 = cA + (size_t)(t + 1) * kstep;
            const char* a2 = last ? nA : cA + (size_t)(t + 2) * kstep; const char* b2 = last ? nB : cB + (size_t)(t + 2) * kstep;
            const char* a3 = a2 + kstep; const char* b3 = b2 + kstep;
            if (last && has_next) S.a_ready(nxt);
            if constexpr (SP2) {
            PG8_LDB(B0, 0, 0); PG8_LDB(B1, 0, 1); PG8_SCHED; PG8_LDA(At, 0, 0); PG8_STAGE(PG8_SA(1, 1), a1 + hstep, voffA);
            PG8_WAIT_V(8); PG8_WAIT_L(0); PG8_BAR; PG8_MMA(0, 0, At, B0); PG8_MMA(0, 1, At, B1); PG8_BAR; PG8_SCHED;
            PG8_LDA(At, 0, 1); PG8_STAGE(PG8_SB(0, 0), b2, voffB); PG8_STAGE(PG8_SB(0, 1), b2 + hstep, voffB); PG8_STAGE(PG8_SA(0, 0), a2, voffA);
            PG8_WAIT_V(8); PG8_WAIT_L(0); PG8_BAR; PG8_MMA(1, 0, At, B0); PG8_MMA(1, 1, At, B1); PG8_BAR; PG8_SCHED;
            PG8_LDB(B0, 1, 0); PG8_LDB(B1, 1, 1); PG8_SCHED; PG8_LDA(At, 1, 0); PG8_STAGE(PG8_SA(0, 1), a2 + hstep, voffA);
            PG8_WAIT_V(8); PG8_WAIT_L(0); PG8_BAR; PG8_MMA(0, 0, At, B0); PG8_MMA(0, 1, At, B1); PG8_BAR; PG8_SCHED;
            PG8_LDA(At, 1, 1); PG8_STAGE(PG8_SB(1, 0), b3, voffB); PG8_STAGE(PG8_SB(1, 1), b3 + hstep, voffB); PG8_STAGE(PG8_SA(1, 0), a3, voffA);
            PG8_WAIT_V(8); PG8_WAIT_L(0); PG8_BAR; PG8_MMA(1, 0, At, B0); PG8_MMA(1, 1, At, B1); PG8_BAR; PG8_SCHED;
            } else {
            PG8_LDB(B0, 0, 0); PG8_SCHED; PG8_LDA(At, 0, 0); PG8_STAGE(PG8_SA(1, 1), a1 + hstep, voffA);
            PG8_WAIT_L(8); PG8_BAR; PG8_WAIT_L(0); PG8_MMA(0, 0, At, B0); PG8_BAR; PG8_SCHED;
            PG8_LDB(B1, 0, 1); PG8_STAGE(PG8_SB(0, 0), b2, voffB);
            PG8_BAR; PG8_WAIT_L(0); PG8_MMA(0, 1, At, B1); PG8_BAR;
            PG8_LDA(At, 0, 1); PG8_STAGE(PG8_SA(0, 0), a2, voffA);
            PG8_BAR; PG8_WAIT_L(0); PG8_MMA(1, 0, At, B0); PG8_BAR; PG8_SCHED;
            PG8_STAGE(PG8_SB(0, 1), b2 + hstep, voffB);
            PG8_WAIT_V(6); PG8_BAR; PG8_MMA(1, 1, At, B1); PG8_BAR;
            PG8_LDB(B0, 1, 0); PG8_SCHED; PG8_LDA(At, 1, 0); PG8_STAGE(PG8_SA(0, 1), a2 + hstep, voffA);
            PG8_WAIT_L(8); PG8_BAR; PG8_WAIT_L(0); PG8_MMA(0, 0, At, B0); PG8_BAR; PG8_SCHED;
            PG8_LDB(B1, 1, 1); PG8_STAGE(PG8_SB(1, 0), b3, voffB);
            PG8_BAR; PG8_WAIT_L(0); PG8_MMA(0, 1, At, B1); PG8_BAR;
            PG8_LDA(At, 1, 1); PG8_STAGE(PG8_SA(1, 0), a3, voffA);
            PG8_BAR; PG8_WAIT_L(0); PG8_MMA(1, 0, At, B0); PG8_BAR; PG8_SCHED;
            PG8_STAGE(PG8_SB(1, 1), b3 + hstep, voffB);
            PG8_WAIT_V(6); PG8_BAR; PG8_MMA(1, 1, At, B1); PG8_BAR;
            }
        }
        if constexpr (ALIGN_EPI) { if (wr == 0) PG8_BAR; }
        if constexpr (!Epi::AFTER_DRAIN) { E(acc, cur, wr, wc, fr, fq); S.done(cur); }
        if (!has_next) break;
#pragma unroll
        for (int a = 0; a < 2; ++a)
#pragma unroll
            for (int b = 0; b < 2; ++b)
#pragma unroll
                for (int m = 0; m < 4; ++m)
#pragma unroll
                    for (int n = 0; n < 2; ++n) acc[a][b][m][n] = (f32x4){0.f, 0.f, 0.f, 0.f};
        cur = nxt; cA = nA; cB = nB; ++ui;
        if constexpr (ALIGN_EPI) { if (wr == 1) PG8_BAR; }
    }
    PG8_WAIT_V(0);
    if constexpr (!ALIGN_EPI) { if (wr == 0) PG8_BAR; }
    PG8_BAR;
    if constexpr (Epi::AFTER_DRAIN) { E.fused(acc, cur, wr, wc, fr, fq, lds, wid, lane); S.done(cur); }
#undef PG8_SA
#undef PG8_SB
#undef PG8_STAGE
#undef PG8_LDA
#undef PG8_LDB
#undef PG8_MMA
#undef PG8_WAIT_V
#undef PG8_WAIT_L
#undef PG8_BAR
#undef PG8_SCHED
}
}
using pg8::bf16_t; using pg8::bf16x8; using pg8::f32x4; using pg8::u32x4;
typedef unsigned u32x2 __attribute__((ext_vector_type(2)));
constexpr int NWAVES = 8;
constexpr int M_TOK = 16384, DM = 1024, SEQ = 2048, DEPTH = 4, IN_COLS = 9216;
constexpr int N_MAIN = 7168, N_SW = 2048;
constexpr float EPS = 1e-6f;
constexpr float LOG2E = 1.4426950408889634f;
constexpr float QSCALE = 0.125f * LOG2E;
constexpr size_t MiB = 1u << 20;
constexpr size_t WS_XSQ = 0;
constexpr size_t WS_VSQ = 512 * 1024;
constexpr size_t WS_BAR = 768 * 1024;
constexpr size_t WS_WM = 1 * MiB;
constexpr size_t WS_WT_MAIN = 2 * MiB;
constexpr size_t WS_WT_SW = 58 * MiB;
constexpr size_t WS_WT_A = 74 * MiB, WS_WT_B = 82 * MiB, WS_WT_O = 90 * MiB;
constexpr size_t WS_XB = 98 * MiB, WS_XBP = 130 * MiB;
constexpr size_t WS_ACT = 162 * MiB;
constexpr size_t ACT_STRIDE = (size_t)M_TOK * DM;
constexpr int P_T = M_TOK + 64;
constexpr int P_K = DM + 64;
constexpr size_t WS_GVT = 386 * MiB, WS_VT = 419 * MiB;
constexpr size_t WS_T = 452 * MiB;
constexpr size_t WS_MG = 516 * MiB;
constexpr size_t WS_END = 550 * MiB;
constexpr int RING_BYTES = 131072, LDS_BYTES = 147456;

#define GAS __attribute__((address_space(1)))
#define LAS __attribute__((address_space(3)))

__device__ __forceinline__ float bf2f(unsigned short h) { return __builtin_bit_cast(float, (unsigned)h << 16); }
__device__ __forceinline__ float bflo(unsigned w) { return __builtin_bit_cast(float, w << 16); }
__device__ __forceinline__ float bfhi(unsigned w) { return __builtin_bit_cast(float, w & 0xffff0000u); }
__device__ __forceinline__ unsigned pkbf(float lo, float hi) { return pg8::cvt_pk_bf16(lo, hi); }
__device__ __forceinline__ float sigm(float z) { return __builtin_amdgcn_rcpf(1.f + __builtin_amdgcn_exp2f(-LOG2E * z)); }
__device__ __forceinline__ float gelu_t(float v) { const float z = 1.5957691216057308f * v * (1.f + 0.044715f * v * v); return v * sigm(z); }
__device__ __forceinline__ float rs_of(float ss) { return __builtin_amdgcn_rsqf(ss * (1.0f / 1024.0f) + EPS); }
__device__ __forceinline__ int pi_row(int row) { return (row & ~2047) | ((row & 3) << 9) | ((row & 2047) >> 2); }
__device__ __forceinline__ int pi_inv(int p) { return (p & ~2047) | ((p & 511) << 2) | ((p >> 9) & 3); }

__device__ __forceinline__ size_t cm_off(int p, int chan) { return ((size_t)((((p >> 11) * 4 + ((p >> 9) & 3)) * 16 + ((p >> 5) & 15)) * 1024 + chan)) * 32 + (p & 31); }
__device__ __forceinline__ size_t kb_off(int row, int col) { const int b = row >> 11, tl = row & 2047; return (size_t)(((((b * 16 + (col >> 6)) * 4 + (tl & 3)) * 16 + (tl >> 7)) * 32 + ((tl >> 2) & 31))) * 64 + (col & 63); }
struct EpiMain {
    static constexpr bool PERM = true, AFTER_DRAIN = false, MIDK = false;
    bf16_t* O; const float* xsq; bf16_t* KB;
    __device__ __forceinline__ void operator()(const f32x4 (&acc)[2][2][4][2], const pg8::Unit& u, int wr, int wc, int fr, int fq) const {
        asm volatile("" : "+v"(fr), "+v"(fq));
        const int seg = u.pn >> 2;
        bf16_t* base = O + (size_t)seg * ACT_STRIDE;
        const int col0 = (u.pn & 3) * 256 + wc * 32 + 8 * fq, row0 = u.pm * 256 + wr * 64 + fr;
        const float lin = seg == 2 ? QSCALE : 1.f;
#pragma unroll
        for (int ai = 0; ai < 2; ++ai)
#pragma unroll
            for (int m = 0; m < 4; ++m) { const int row = row0 + ai * 128 + m * 16; const float rs = rs_of(xsq[row]); const float rl = rs * lin; bf16_t* rowp = seg == 3 ? KB + kb_off(row, col0) : base + (size_t)row * DM + col0;
#pragma unroll
                for (int bj = 0; bj < 2; ++bj) { float v[8];
                    if (seg >= 5) {
#pragma unroll
                        for (int e = 0; e < 4; ++e) { v[e] = sigm(acc[ai][bj][m][0][e] * rs); v[4 + e] = sigm(acc[ai][bj][m][1][e] * rs); }
                    } else {
#pragma unroll
                        for (int e = 0; e < 4; ++e) { v[e] = acc[ai][bj][m][0][e] * rl; v[4 + e] = acc[ai][bj][m][1][e] * rl; }
                    }
                    u32x4 w; w.x = pkbf(v[0], v[1]); w.y = pkbf(v[2], v[3]); w.z = pkbf(v[4], v[5]); w.w = pkbf(v[6], v[7]);
                    *(u32x4*)(rowp + (seg == 3 ? 2 * 32 * 16 * 4 * 64 * bj : 128 * bj)) = w; } }
    }
};
struct EpiSw {
    static constexpr bool PERM = true, AFTER_DRAIN = false, MIDK = false;
    bf16_t* GVT; bf16_t* VT; const float* xsq; float* vsq;
    __device__ __forceinline__ void operator()(const f32x4 (&acc)[2][2][4][2], const pg8::Unit& u, int wr, int wc, int fr, int fq) const {
        asm volatile("" : "+v"(fr), "+v"(fq));
        const int colbase = u.pn * 256 + wc * 32 + 8 * fq;
        float cs[2][8];
#pragma unroll
        for (int bj = 0; bj < 2; ++bj)
#pragma unroll
            for (int e = 0; e < 8; ++e) cs[bj][e] = rs_of(xsq[pi_inv(colbase + bj * 128 + e)]);
        const bool isv = u.pm >= 4;
        bf16_t* out = isv ? VT : GVT; const int chan0 = (isv ? u.pm - 4 : u.pm) * 256;
        const int row0 = wr * 64 + fr;
        float ss[2][8];
#pragma unroll
        for (int bj = 0; bj < 2; ++bj)
#pragma unroll
            for (int e = 0; e < 8; ++e) ss[bj][e] = 0.f;
#pragma unroll
        for (int ai = 0; ai < 2; ++ai)
#pragma unroll
            for (int m = 0; m < 4; ++m) { bf16_t* rowp = out + cm_off(colbase, chan0 + row0 + ai * 128 + m * 16);
#pragma unroll
                for (int bj = 0; bj < 2; ++bj) { float v[8];
#pragma unroll
                    for (int e = 0; e < 4; ++e) { v[e] = acc[ai][bj][m][0][e] * cs[bj][e]; v[4 + e] = acc[ai][bj][m][1][e] * cs[bj][4 + e]; }
                    if (!isv) {
#pragma unroll
                        for (int e = 0; e < 8; ++e) { v[e] = gelu_t(v[e]); ss[bj][e] += v[e] * v[e]; } }
                    u32x4 w; w.x = pkbf(v[0], v[1]); w.y = pkbf(v[2], v[3]); w.z = pkbf(v[4], v[5]); w.w = pkbf(v[6], v[7]);
                    *(u32x4*)(rowp + bj * 4 * 1024 * 32) = w; } }
        if (!isv) {
            float mine = 0.f;
#pragma unroll
            for (int bj = 0; bj < 2; ++bj)
#pragma unroll
                for (int e = 0; e < 8; ++e) { float s = ss[bj][e];
                    s += __shfl_xor(s, 1); s += __shfl_xor(s, 2); s += __shfl_xor(s, 4); s += __shfl_xor(s, 8);
                    if (fr == bj * 8 + e) mine = s; }
            atomicAdd(vsq + colbase + (fr >> 3) * 128 + (fr & 7), mine);
        }
    }
};
struct EpiMerge2 {
    static constexpr bool PERM = true, AFTER_DRAIN = false, MIDK = true;
    const bf16_t* GA; const bf16_t* GB; bf16_t* MG;
    __device__ __forceinline__ void mid(f32x4 (&acc)[2][2][4][2], const pg8::Unit& u, int wr, int wc, int fr, int fq) const {
        asm volatile("" : "+v"(fr), "+v"(fq));
        const int col0 = u.pn * 256 + wc * 32 + 8 * fq, row0 = u.pm * 256 + wr * 64 + fr;
#pragma unroll
        for (int ai = 0; ai < 2; ++ai)
#pragma unroll
            for (int m = 0; m < 4; ++m)
#pragma unroll
                for (int bj = 0; bj < 2; ++bj) { const size_t off = (size_t)(row0 + ai * 128 + m * 16) * DM + col0 + bj * 128;
                    const u32x4 ga = *(const u32x4*)(GA + off), gb = *(const u32x4*)(GB + off);
                    f32x4 r0, r1;
                    r0[0] = bflo(ga.x) * __builtin_amdgcn_rcpf(bflo(gb.x)); r0[1] = bfhi(ga.x) * __builtin_amdgcn_rcpf(bfhi(gb.x)); r0[2] = bflo(ga.y) * __builtin_amdgcn_rcpf(bflo(gb.y)); r0[3] = bfhi(ga.y) * __builtin_amdgcn_rcpf(bfhi(gb.y));
                    r1[0] = bflo(ga.z) * __builtin_amdgcn_rcpf(bflo(gb.z)); r1[1] = bfhi(ga.z) * __builtin_amdgcn_rcpf(bfhi(gb.z)); r1[2] = bflo(ga.w) * __builtin_amdgcn_rcpf(bflo(gb.w)); r1[3] = bfhi(ga.w) * __builtin_amdgcn_rcpf(bfhi(gb.w));
                    acc[ai][bj][m][0] = acc[ai][bj][m][0] * r0; acc[ai][bj][m][1] = acc[ai][bj][m][1] * r1; }
    }
    __device__ __forceinline__ void operator()(const f32x4 (&acc)[2][2][4][2], const pg8::Unit& u, int wr, int wc, int fr, int fq) const {
        asm volatile("" : "+v"(fr), "+v"(fq));
        const int col0 = u.pn * 256 + wc * 32 + 8 * fq, row0 = u.pm * 256 + wr * 64 + fr;
#pragma unroll
        for (int ai = 0; ai < 2; ++ai)
#pragma unroll
            for (int m = 0; m < 4; ++m)
#pragma unroll
                for (int bj = 0; bj < 2; ++bj) { const size_t off = (size_t)(row0 + ai * 128 + m * 16) * DM + col0 + bj * 128;
                    const u32x4 g = *(const u32x4*)(GB + off);
                    f32x4 a, b; a[0] = bflo(g.x); a[1] = bfhi(g.x); a[2] = bflo(g.y); a[3] = bfhi(g.y); b[0] = bflo(g.z); b[1] = bfhi(g.z); b[2] = bflo(g.w); b[3] = bfhi(g.w);
                    const f32x4 r0 = a * acc[ai][bj][m][0], r1 = b * acc[ai][bj][m][1];
                    u32x4 w; w.x = pkbf(r0[0], r0[1]); w.y = pkbf(r0[2], r0[3]); w.z = pkbf(r1[0], r1[1]); w.w = pkbf(r1[2], r1[3]);
                    *(u32x4*)(MG + off) = w; }
    }
};
struct EpiOut {
    static constexpr bool PERM = true, AFTER_DRAIN = false, MIDK = false;
    const float* xin; float* xout; bf16_t* xb; bf16_t* xbp; float* xsq_next;
    __device__ __forceinline__ void operator()(const f32x4 (&acc)[2][2][4][2], const pg8::Unit& u, int wr, int wc, int fr, int fq) const {
        asm volatile("" : "+v"(fr), "+v"(fq));
        const int col0 = u.pn * 256 + wc * 32 + 8 * fq, row0 = u.pm * 256 + wr * 64 + fr;
#pragma unroll
        for (int ai = 0; ai < 2; ++ai)
#pragma unroll
            for (int m = 0; m < 4; ++m) { const int row = row0 + ai * 128 + m * 16, prow = pi_row(row); float ss = 0.f;
#pragma unroll
                for (int bj = 0; bj < 2; ++bj) { const size_t off = (size_t)row * DM + col0 + bj * 128;
                    const f32x4 r0 = *(const f32x4*)(xin + off) + acc[ai][bj][m][0], r1 = *(const f32x4*)(xin + off + 4) + acc[ai][bj][m][1];
                    *(f32x4*)(xout + off) = r0; *(f32x4*)(xout + off + 4) = r1;
                    ss += (r0[0] * r0[0] + r0[1] * r0[1]) + (r0[2] * r0[2] + r0[3] * r0[3]) + (r1[0] * r1[0] + r1[1] * r1[1]) + (r1[2] * r1[2] + r1[3] * r1[3]);
                    u32x4 w; w.x = pkbf(r0[0], r0[1]); w.y = pkbf(r0[2], r0[3]); w.z = pkbf(r1[0], r1[1]); w.w = pkbf(r1[2], r1[3]);
                    *(u32x4*)(xb + off) = w; *(u32x4*)(xbp + (size_t)prow * DM + col0 + bj * 128) = w; }
                ss += __shfl_xor(ss, 16); ss += __shfl_xor(ss, 32);
                if (fq == 0) atomicAdd(xsq_next + row, ss); }
    }
};
struct MixP { const bf16_t* WM; const bf16_t* GVT; const bf16_t* VT; const bf16_t* K; bf16_t* U; bf16_t* Q; const bf16_t* AG; const bf16_t* BG; const float* vsq; const float* b_s; const float* g_v; bf16_t* UO; bf16_t* QO; };
#define MFMA16(a, b, c) __builtin_amdgcn_mfma_f32_16x16x32_bf16((a), (b), (c), 0, 0, 0)

__device__ __forceinline__ void gating_stage(const MixP& p, int itw, LAS unsigned char* buf, int wave, int lane) {
    const int g = itw & 7, c = (itw >> 3) & 15, b = itw >> 7, r16 = lane >> 2, pp = lane & 3;
#pragma unroll
    for (int q = 0; q < 4; ++q) { const int chunk = wave * 4 + q, dt = chunk >> 2, ks = chunk & 3;
        const bf16_t* src = p.GVT + ((size_t)(((b * 4 + ks) * 16 + c) * 1024 + g * 128 + 16 * dt + r16)) * 32 + 8 * (pp ^ ((r16 >> 2) & 3));
        __builtin_amdgcn_global_load_lds((const unsigned*)src, (LAS unsigned*)(buf + chunk * 1024), 16, 0, 0); }
}
__device__ __forceinline__ void gating_item(const MixP& p, int layer, int it, int lane, const LAS unsigned char* tile, LAS unsigned char* io) {
    const int tt = it & 7, g = (it >> 3) & 7, c = (it >> 6) & 15, b = it >> 10;
    const int j = lane & 15, kg = lane >> 4;
    const bf16_t* wm = p.WM + ((size_t)((layer * 8 + g) * 128 + 16 * tt + j)) * 128 + 8 * kg;
    const size_t tok0 = (size_t)b * 2048 + 128 * c + 16 * tt;
    { const int rr = lane >> 4, pos = lane & 15;
#pragma unroll
      for (int q = 0; q < 4; ++q) { const int row = 4 * q + rr; const size_t off = (tok0 + row) * DM + g * 128 + 8 * (pos ^ row);
          __builtin_amdgcn_global_load_lds((const unsigned*)(p.U + off), (LAS unsigned*)(io + q * 1024), 16, 0, 0);
          __builtin_amdgcn_global_load_lds((const unsigned*)(p.AG + off), (LAS unsigned*)(io + 4096 + q * 1024), 16, 0, 0); } }
    const int t = 16 * tt + j;
    const float bias = p.b_s[(layer * 8 + g) * 128 + t];
    f32x4 acc[8];
#pragma unroll
    for (int dt = 0; dt < 8; ++dt) acc[dt] = (f32x4){0.f, 0.f, 0.f, 0.f};
    bf16x8 bfr[4];
#pragma unroll
    for (int ks = 0; ks < 4; ++ks) {
        const int pb = b * 2048 + ks * 512 + 32 * c + 8 * kg;
        const u32x4 wraw = *(const u32x4*)(wm + 32 * ks);
        const f32x4 q0 = *(const f32x4*)(p.vsq + pb), q1 = *(const f32x4*)(p.vsq + pb + 4);
        u32x4 bw;
        bw.x = pkbf(bflo(wraw.x) * rs_of(q0[0]), bfhi(wraw.x) * rs_of(q0[1])); bw.y = pkbf(bflo(wraw.y) * rs_of(q0[2]), bfhi(wraw.y) * rs_of(q0[3]));
        bw.z = pkbf(bflo(wraw.z) * rs_of(q1[0]), bfhi(wraw.z) * rs_of(q1[1])); bw.w = pkbf(bflo(wraw.w) * rs_of(q1[2]), bfhi(wraw.w) * rs_of(q1[3]));
        bfr[ks] = __builtin_bit_cast(bf16x8, bw);
    }
#pragma unroll
    for (int ks = 0; ks < 4; ++ks) {
#pragma unroll
        for (int dt = 0; dt < 8; ++dt) { const bf16x8 afr = *(const LAS bf16x8*)(tile + (dt * 4 + ks) * 1024 + (j * 4 + (kg ^ ((j >> 2) & 3))) * 16); acc[dt] = MFMA16(afr, bfr[ks], acc[dt]); }
    }
    asm volatile("s_waitcnt vmcnt(0)" ::: "memory");
#pragma unroll
    for (int dt = 0; dt < 8; ++dt) { const int d4 = g * 128 + 16 * dt + 4 * kg; LAS unsigned char* cell = io + j * 256 + (((2 * dt + (kg >> 1)) ^ j) & 15) * 16 + (kg & 1) * 8;
        const f32x4 gv = *(const f32x4*)(p.g_v + layer * 1024 + d4);
        const u32x2 u2 = *(const LAS u32x2*)cell, a2 = *(const LAS u32x2*)(cell + 4096);
        const float g0 = bflo(a2.x), g1 = bfhi(a2.x), g2 = bflo(a2.y), g3 = bfhi(a2.y);
        const float y0 = gelu_t(bflo(u2.x)) * (acc[dt][0] * gv[0] + bias) * (g0 * sigm(g0)), y1 = gelu_t(bfhi(u2.x)) * (acc[dt][1] * gv[1] + bias) * (g1 * sigm(g1));
        const float y2 = gelu_t(bflo(u2.y)) * (acc[dt][2] * gv[2] + bias) * (g2 * sigm(g2)), y3 = gelu_t(bfhi(u2.y)) * (acc[dt][3] * gv[3] + bias) * (g3 * sigm(g3));
        u32x2 w; w.x = pkbf(y0, y1); w.y = pkbf(y2, y3); *(LAS u32x2*)cell = w; }
    { const int rr = lane >> 4, pos = lane & 15;
#pragma unroll
      for (int q = 0; q < 4; ++q) { const int row = 4 * q + rr; const u32x4 v = *(const LAS u32x4*)(io + q * 1024 + lane * 16);
          *(u32x4*)(p.UO + (tok0 + row) * 2048 + g * 128 + 8 * (pos ^ row)) = v; } }
}

constexpr int ATS = 576;
__device__ __forceinline__ void build_bias_table(LAS float* tbl, int h, int tid) {
    const float slope2 = __builtin_amdgcn_exp2f(-0.5f * (float)(h + 1)) * LOG2E;
    for (int i = tid; i < 4 * ATS; i += NWAVES * 64) { const int res = i / ATS, q = i % ATS - 32, dlt = 4 * q + res;
        const int c = (int)(dlt <= 128) + (int)((res == 0) & (dlt <= 512)) + (int)((dlt & 15) == 0);
        const float lg = c == 3 ? 1.5849625007f : (c == 2 ? 1.f : 0.f);
        tbl[i] = (dlt >= 0 && dlt < 2048 && c > 0) ? (lg - slope2 * (float)dlt) : -INFINITY; }
}
struct KVF { bf16x8 kf[2][2]; bf16x8 vf[4]; };
template <int N> __device__ __forceinline__ void attn_wait_v(bf16x8 (&vf)[4]) { (void)vf; }
__device__ __forceinline__ int kswz(int n) { return ((n >> 1) & 1) | (((n >> 3) & 3) << 1); }
__device__ __forceinline__ void attn_dma(const bf16_t* Kbh, const bf16_t* Vbh, int sc, int rp, int lane, LAS unsigned char* stage) {
    const bf16_t* kblk = Kbh + (size_t)((rp * 16 + sc) * 32) * 64;
    const bf16_t* vblk = Vbh + (size_t)((rp * 16 + sc) * 1024) * 32;
#pragma unroll
    for (int q = 0; q < 4; ++q) { const int n = 8 * q + (lane >> 3), pp = lane & 7;
        __builtin_amdgcn_global_load_lds((const unsigned*)(kblk + n * 64 + 8 * (pp ^ kswz(n))), (LAS unsigned*)(stage + q * 1024), 16, 0, 0); }
#pragma unroll
    for (int q = 0; q < 4; ++q) { const int r = 16 * q + (lane >> 2), pp = lane & 3;
        __builtin_amdgcn_global_load_lds((const unsigned*)(vblk + r * 32 + 8 * (pp ^ ((r >> 2) & 3))), (LAS unsigned*)(stage + (4 + q) * 1024), 16, 0, 0); }
}
__device__ __forceinline__ void attn_fetch(bf16x8 (&kf)[2][2], bf16x8 (&vf)[4], const LAS unsigned char* stage, int lane) {
    const int j = lane & 15, kg = lane >> 4;
#pragma unroll
    for (int a = 0; a < 2; ++a) { const int n = 8 * (j >> 2) + 4 * a + (j & 3);
#pragma unroll
        for (int ks = 0; ks < 2; ++ks) kf[a][ks] = *(const LAS bf16x8*)(stage + n * 128 + ((4 * ks + kg) ^ kswz(n)) * 16); }
#pragma unroll
    for (int dt = 0; dt < 4; ++dt) vf[dt] = *(const LAS bf16x8*)(stage + 4096 + (16 * dt + j) * 64 + (kg ^ ((j >> 2) & 3)) * 16);
}
__device__ __forceinline__ float attn_newmax(float mx, float& m, float& l, f32x4 (&o)[4]) {
    { auto r16 = __builtin_amdgcn_permlane16_swap(__float_as_uint(mx), __float_as_uint(mx), false, false); mx = fmaxf(__uint_as_float(r16[0]), __uint_as_float(r16[1]));
      auto r32 = __builtin_amdgcn_permlane32_swap(__float_as_uint(mx), __float_as_uint(mx), false, false); mx = fmaxf(__uint_as_float(r32[0]), __uint_as_float(r32[1])); }
    const float mnew = fmaxf(m, mx);
    if (__any(mnew > m)) { const float alpha = __builtin_amdgcn_exp2f(m - mnew); l *= alpha;
#pragma unroll
        for (int dt = 0; dt < 4; ++dt) o[dt] = o[dt] * alpha; }
    m = mnew; return mnew;
}
template <int NV> __device__ __forceinline__ void attn_compute(const bf16x8 (&kf)[2][2], bf16x8 (&vf)[4], const LAS float* tb0, const bf16x8 (&qf)[2][2], f32x4 (&o)[2][4], float (&m)[2], float (&l)[2]) {
    bf16x8 pf[2];
#pragma unroll
    for (int qt = 0; qt < 2; ++qt) {
        f32x4 s[2];
#pragma unroll
        for (int a = 0; a < 2; ++a) { s[a] = MFMA16(kf[a][0], qf[qt][0], ((f32x4){0.f, 0.f, 0.f, 0.f})); s[a] = MFMA16(kf[a][1], qf[qt][1], s[a]); }
        const LAS float* tb = tb0 + 16 * qt;
        float sv[8]; float mx = -1e30f;
#pragma unroll
        for (int a = 0; a < 2; ++a)
#pragma unroll
            for (int r = 0; r < 4; ++r) { const float x = s[a][r] + tb[7 - 4 * a - r]; sv[4 * a + r] = x; mx = fmaxf(mx, x); }
        const float mnew = attn_newmax(mx, m[qt], l[qt], o[qt]);
        float ps = 0.f;
#pragma unroll
        for (int e = 0; e < 8; ++e) { sv[e] = __builtin_amdgcn_exp2f(sv[e] - mnew); ps += sv[e]; }
        l[qt] += ps;
        u32x4 pw; pw.x = pkbf(sv[0], sv[1]); pw.y = pkbf(sv[2], sv[3]); pw.z = pkbf(sv[4], sv[5]); pw.w = pkbf(sv[6], sv[7]);
        pf[qt] = __builtin_bit_cast(bf16x8, pw);
    }
    attn_wait_v<NV>(vf);
#pragma unroll
    for (int dt = 0; dt < 4; ++dt)
#pragma unroll
        for (int qt = 0; qt < 2; ++qt) o[qt][dt] = MFMA16(vf[dt], pf[qt], o[qt][dt]);
}
template <int NV> __device__ __forceinline__ void attn_compute_far(const bf16x8 (&kf)[2][2], bf16x8 (&vf)[4], const LAS float* tb0, int j, const bf16x8 (&qf)[2][2], f32x4 (&o)[2][4], float (&m)[2], float (&l)[2]) {
    bf16x8 pf[2];
    const int rs_ = j & 3; const bool r1 = (rs_ & 1) != 0, r2 = (rs_ & 2) != 0;
#pragma unroll
    for (int qt = 0; qt < 2; ++qt) {
        float x[2];
#pragma unroll
        for (int a = 0; a < 2; ++a) { f32x4 s = MFMA16(kf[a][0], qf[qt][0], ((f32x4){0.f, 0.f, 0.f, 0.f})); s = MFMA16(kf[a][1], qf[qt][1], s);
            const float lo = r1 ? s[1] : s[0], hi = r1 ? s[3] : s[2]; x[a] = (r2 ? hi : lo) + tb0[16 * qt + 7 - 4 * a - rs_]; }
        const float mnew = attn_newmax(fmaxf(x[0], x[1]), m[qt], l[qt], o[qt]);
        const float p0 = __builtin_amdgcn_exp2f(x[0] - mnew), p1 = __builtin_amdgcn_exp2f(x[1] - mnew);
        l[qt] += p0 + p1;
        const unsigned w0 = pkbf(r1 ? 0.f : p0, r1 ? p0 : 0.f), w1 = pkbf(r1 ? 0.f : p1, r1 ? p1 : 0.f);
        u32x4 pw; pw.x = r2 ? 0u : w0; pw.y = r2 ? w0 : 0u; pw.z = r2 ? 0u : w1; pw.w = r2 ? w1 : 0u;
        pf[qt] = __builtin_bit_cast(bf16x8, pw);
    }
    attn_wait_v<NV>(vf);
#pragma unroll
    for (int dt = 0; dt < 4; ++dt)
#pragma unroll
        for (int qt = 0; qt < 2; ++qt) o[qt][dt] = MFMA16(vf[dt], pf[qt], o[qt][dt]);
}
__device__ __forceinline__ void attn_item(const MixP& p, const LAS float* tbl, int b, int h, int nb, int rho, int lane) {
    const int j = lane & 15, kg = lane >> 4; const size_t rowb = (size_t)b * 2048;
    const bf16_t* Kh = p.K + (size_t)((b * 16 + h) * 4) * 16 * 32 * 64;
    const bf16_t* Vh = p.VT + ((size_t)(b * 4) * 16 * 1024 + h * 64) * 32;
    f32x4 o[2][4]; float m[2] = {-1e30f, -1e30f}, l[2] = {0.f, 0.f};
#pragma unroll
    for (int qt = 0; qt < 2; ++qt)
#pragma unroll
        for (int dt = 0; dt < 4; ++dt) o[qt][dt] = (f32x4){0.f, 0.f, 0.f, 0.f};
    const int lb = 4 * j - 32 * kg, sc0 = nb > 0 ? nb - 1 : 0, nnear = 3 * (nb - sc0 + 1), nst = nb + 1 + nnear;
#define ATT_DECODE(t, sc_, rp_) do { if ((t) == 0) { sc_ = nb; rp_ = rho; } else if ((t) <= nnear) { const int e_ = (t) - 1; sc_ = nb - e_ / 3; rp_ = (rho + 1 + e_ % 3) & 3; } else { sc_ = nb - ((t) - nnear); rp_ = rho; } } while (0)
    LAS unsigned char* ring = (LAS unsigned char*)tbl - (RING_BYTES + 1024) + __builtin_amdgcn_readfirstlane((int)(threadIdx.x >> 6)) * 16384;
    const int R8 = lane >> 3, pos8 = lane & 7;
#define ATT_ROWTOK(R) (rowb + 128 * nb + 64 * ((R) >> 4) + rho + 4 * ((R) & 15))
#pragma unroll
    for (int q = 0; q < 4; ++q) { const int R = 8 * q + R8;
        __builtin_amdgcn_global_load_lds((const unsigned*)(p.Q + ATT_ROWTOK(R) * DM + h * 64 + 8 * (pos8 ^ ((R >> 1) & 7))), (LAS unsigned*)(ring + 8192 + q * 1024), 16, 0, 0); }
    { int sc_, rp_; ATT_DECODE(0, sc_, rp_); attn_dma(Kh, Vh, sc_, rp_, lane, ring); }
    asm volatile("s_waitcnt vmcnt(8)" ::: "memory");
    bf16x8 qf[2][2];
#pragma unroll
    for (int qt = 0; qt < 2; ++qt) { const int R = 16 * qt + j;
#pragma unroll
        for (int ks = 0; ks < 2; ++ks) qf[qt][ks] = *(const LAS bf16x8*)(ring + 8192 + R * 128 + ((4 * ks + kg) ^ ((R >> 1) & 7)) * 16); }
    asm volatile("s_waitcnt lgkmcnt(0)" : "+v"(qf[0][0]), "+v"(qf[0][1]), "+v"(qf[1][0]), "+v"(qf[1][1]) : : "memory");
    if (nst > 1) { int sc_, rp_; ATT_DECODE(1, sc_, rp_); attn_dma(Kh, Vh, sc_, rp_, lane, ring + 8192); }
    for (int t = 0; t < nst; ++t) {
        LAS unsigned char* stage = ring + (t & 1) * 8192;
        if (t + 1 < nst) asm volatile("s_waitcnt vmcnt(8)" ::: "memory"); else asm volatile("s_waitcnt vmcnt(0)" ::: "memory");
        bf16x8 kf[2][2], vf[4];
        attn_fetch(kf, vf, stage, lane);
        asm volatile("s_waitcnt lgkmcnt(0)" : "+v"(kf[0][0]), "+v"(kf[0][1]), "+v"(kf[1][0]), "+v"(kf[1][1]), "+v"(vf[0]), "+v"(vf[1]), "+v"(vf[2]), "+v"(vf[3]) : : "memory");
        if (t + 2 < nst) { int sc_, rp_; ATT_DECODE(t + 2, sc_, rp_); attn_dma(Kh, Vh, sc_, rp_, lane, stage); }
        if (t + 1 == nst) {
#pragma unroll
            for (int q = 0; q < 4; ++q) { const int R = 8 * q + R8;
                __builtin_amdgcn_global_load_lds((const unsigned*)(p.BG + ATT_ROWTOK(R) * DM + h * 64 + 8 * (pos8 ^ ((R >> 1) & 7))), (LAS unsigned*)(ring + ((t + 1) & 1) * 8192 + q * 1024), 16, 0, 0); } }
        int sc_, rp_; ATT_DECODE(t, sc_, rp_);
        const int d0 = 128 * (nb - sc_) + (rho - rp_) + lb; const LAS float* tb0 = tbl + ((d0 & 3) * ATS + (d0 >> 2) + 32 - 7);
        if (nb - sc_ >= 5) attn_compute_far<0>(kf, vf, tb0, j, qf, o, m, l); else attn_compute<0>(kf, vf, tb0, qf, o, m, l);
    }
#undef ATT_DECODE
    asm volatile("s_waitcnt vmcnt(0)" ::: "memory");
    LAS unsigned char* bgst = ring + (nst & 1) * 8192; LAS unsigned char* outst = ring + ((nst + 1) & 1) * 8192;
#pragma unroll
    for (int qt = 0; qt < 2; ++qt) { float lt = l[qt]; lt += __shfl_xor(lt, 16); lt += __shfl_xor(lt, 32); const float inv = 1.0f / lt;
        const int R = 16 * qt + j;
#pragma unroll
        for (int dt = 0; dt < 4; ++dt) { const int cell = R * 128 + (((2 * dt + (kg >> 1)) ^ ((R >> 1) & 7)) * 16) + (kg & 1) * 8;
            const u32x2 g2 = *(const LAS u32x2*)(bgst + cell);
            const float b0 = bflo(g2.x), b1 = bfhi(g2.x), b2 = bflo(g2.y), b3 = bfhi(g2.y);
            u32x2 w; w.x = pkbf(o[qt][dt][0] * inv * (b0 * sigm(b0)), o[qt][dt][1] * inv * (b1 * sigm(b1))); w.y = pkbf(o[qt][dt][2] * inv * (b2 * sigm(b2)), o[qt][dt][3] * inv * (b3 * sigm(b3)));
            *(LAS u32x2*)(outst + cell) = w; } }
#pragma unroll
    for (int q = 0; q < 4; ++q) { const int R = 8 * q + R8; const u32x4 v = *(const LAS u32x4*)(outst + q * 1024 + lane * 16);
        *(u32x4*)(p.QO + ATT_ROWTOK(R) * 2048 + h * 64 + 8 * (pos8 ^ ((R >> 1) & 7))) = v; }
    asm volatile("s_waitcnt lgkmcnt(0)" ::: "memory");
#undef ATT_ROWTOK
}

__device__ __forceinline__ float wave_sum(float v) {
#pragma unroll
    for (int o = 1; o < 64; o <<= 1) v += __shfl_xor(v, o);
    return v;
}
__device__ __forceinline__ void tr_tile(const float* W, int N, int k0, int n0, const float* gk, bf16_t* dst, int K, LAS float* scr, int lane) {
#pragma unroll 8
    for (int i = 0; i < 32; ++i) { const int kk = 2 * i + (lane >> 5); float v = W[(size_t)(k0 + kk) * N + n0 + (lane & 31)]; if (gk) v *= gk[k0 + kk]; scr[kk * 33 + (lane & 31)] = v; }
    asm volatile("s_waitcnt lgkmcnt(0)" ::: "memory");
    const int c = lane & 7;
#pragma unroll
    for (int jj = 0; jj < 4; ++jj) { const int n = (lane >> 3) + 8 * jj; const LAS float* s = scr + (8 * c) * 33 + n;
        u32x4 o; o.x = pkbf(s[0 * 33], s[1 * 33]); o.y = pkbf(s[2 * 33], s[3 * 33]); o.z = pkbf(s[4 * 33], s[5 * 33]); o.w = pkbf(s[6 * 33], s[7 * 33]);
        *(u32x4*)(dst + (size_t)n * K + k0 + 8 * c) = o; }
    asm volatile("s_waitcnt lgkmcnt(0)" ::: "memory");
}

#define XB_TMO      128
#define XB_XCNT(j)  (256  + 64 * (j))
#define XB_XSUB(j)  (1280 + 64 * (j))
#define XB_XGEN(j)  (2304 + 64 * (j))
#define XB_TOP      3328
#define XB_TOPGEN   3392
#define XCD_BAR_WORDS 3456
#define XB_SPIN_CAP (1u << 18)

__device__ __forceinline__ unsigned xb_ld(unsigned* p)              { return __hip_atomic_load(p, __ATOMIC_RELAXED, __HIP_MEMORY_SCOPE_AGENT); }
__device__ __forceinline__ unsigned xb_add(unsigned* p, unsigned v) { return __hip_atomic_fetch_add(p, v, __ATOMIC_RELAXED, __HIP_MEMORY_SCOPE_AGENT); }
__device__ __forceinline__ unsigned xb_xcc_id() { return (unsigned)__builtin_amdgcn_s_getreg((3 << 11) | 20) & 0xFu; }
#define XB_SPIN(cond, bar) do { unsigned _sp = 0; while (cond) { __builtin_amdgcn_s_sleep(1); \
    if ((++_sp & 255u) == 0u) { if (xb_ld(&(bar)[XB_TMO])) break; if (_sp > XB_SPIN_CAP) { atomicAdd(&(bar)[XB_TMO], 1u); break; } } } } while (0)

struct XcdBarrier {
    unsigned* bar; unsigned x;
    volatile LAS unsigned* st;
};

__device__ __forceinline__ XcdBarrier xcd_barrier_post(unsigned* bar, volatile LAS unsigned* st) {
    XcdBarrier b; b.bar = bar; b.x = xb_xcc_id(); b.st = st;
    if (threadIdx.x == 0) st[2] = xb_add(&bar[XB_XCNT(b.x)], 1u);
    return b;
}
__device__ __forceinline__ void xcd_barrier_complete(unsigned* bar, unsigned x, unsigned& nloc, unsigned& nx) {
    const unsigned G = gridDim.x * gridDim.y * gridDim.z;
    unsigned sum, cnt, mine, sp = 0u;
    for (;;) {
        sum = 0u; cnt = 0u; mine = 0u;
#pragma unroll
        for (unsigned j = 0; j < 16; ++j) { const unsigned c = xb_ld(&bar[XB_XCNT(j)]); sum += c; cnt += (c > 0u) ? 1u : 0u; mine = (j == x) ? c : mine; }
        if (sum == G) break;
        __builtin_amdgcn_s_sleep(1);
        if ((++sp & 255u) == 0u) { if (xb_ld(&bar[XB_TMO])) break; if (sp > XB_SPIN_CAP) { atomicAdd(&bar[XB_TMO], 1u); break; } }
    }
    nloc = mine > 0u ? mine : 1u; nx = cnt > 0u ? cnt : 1u;
}

__device__ __forceinline__ void xcd_barrier(const XcdBarrier& b) {
    asm volatile("s_waitcnt vmcnt(0)" ::: "memory");
    __syncthreads();
    if (threadIdx.x == 0) {
        unsigned* bar = b.bar;
        __builtin_amdgcn_s_waitcnt(0);
        unsigned nloc = b.st[0], nx = b.st[1];
        if (nloc == 0u) { xcd_barrier_complete(bar, b.x, nloc, nx); b.st[0] = nloc; b.st[1] = nx; }
        const unsigned old = xb_add(&bar[XB_XSUB(b.x)], 1u);
        const unsigned gen = old / nloc;
        if (old + 1u == (gen + 1u) * nloc) {
            __builtin_amdgcn_fence(__ATOMIC_RELEASE, "agent");
            asm volatile("s_waitcnt vmcnt(0)" ::: "memory");
            const unsigned og = xb_add(&bar[XB_TOP], 1u);
            const unsigned tg = og / nx;
            if (og + 1u == (tg + 1u) * nx) xb_add(&bar[XB_TOPGEN], 1u);
            else XB_SPIN(xb_ld(&bar[XB_TOPGEN]) == tg, bar);
            __builtin_amdgcn_fence(__ATOMIC_ACQUIRE, "agent");
            xb_add(&bar[XB_XGEN(b.x)], 1u);
            asm volatile("s_waitcnt vmcnt(0)" ::: "memory");
        } else {
            XB_SPIN(xb_ld(&bar[XB_XGEN(b.x)]) == gen, bar);
            __builtin_amdgcn_fence(__ATOMIC_ACQUIRE, "agent");
            asm volatile("s_waitcnt vmcnt(0)" ::: "memory");
        }
    }
    __syncthreads();
}

__device__ __forceinline__ int lane_id() { int t = threadIdx.x; asm volatile("" : "+v"(t)); return t & 63; }
struct TrDesc { const float* W; const float* gk; bf16_t* dst; int N, k0, n0, K; };
struct TrRegs { f32x4 v[8]; float g[8]; };
__device__ __forceinline__ void tr_load(TrRegs& r, const TrDesc& d, int lane) {
#pragma unroll
    for (int i = 0; i < 8; ++i) { const int kk = 8 * i + (lane >> 3); r.v[i] = *(const f32x4*)(d.W + (size_t)(d.k0 + kk) * d.N + d.n0 + 4 * (lane & 7)); r.g[i] = d.gk ? d.gk[d.k0 + kk] : 1.f; }
}
__device__ __forceinline__ void tr_store(const TrRegs& r, const TrDesc& d, LAS float* scr, int lane) {
#pragma unroll
    for (int i = 0; i < 8; ++i) { const int kk = 8 * i + (lane >> 3); LAS float* sp = scr + kk * 33 + 4 * (lane & 7);
        sp[0] = r.v[i][0] * r.g[i]; sp[1] = r.v[i][1] * r.g[i]; sp[2] = r.v[i][2] * r.g[i]; sp[3] = r.v[i][3] * r.g[i]; }
    asm volatile("s_waitcnt lgkmcnt(0)" ::: "memory");
    const int c = lane & 7;
#pragma unroll
    for (int jj = 0; jj < 4; ++jj) { const int n = (lane >> 3) + 8 * jj; const LAS float* s = scr + (8 * c) * 33 + n;
        u32x4 o; o.x = pkbf(s[0 * 33], s[1 * 33]); o.y = pkbf(s[2 * 33], s[3 * 33]); o.z = pkbf(s[4 * 33], s[5 * 33]); o.w = pkbf(s[6 * 33], s[7 * 33]);
        *(u32x4*)(d.dst + (size_t)n * d.K + d.k0 + 8 * c) = o; }
    asm volatile("s_waitcnt lgkmcnt(0)" ::: "memory");
}
__device__ __forceinline__ TrDesc tr_desc(int it, const float* w_in, const float* g_norm, const float* w_pa, const float* w_pb, const float* w_out, bf16_t* WTM, bf16_t* WTS, bf16_t* WTA, bf16_t* WTO) {
    constexpr int T_IN = 16 * 288, T_SQ = 16 * 32;
    TrDesc d;
    if (it < DEPTH * T_IN) {
        const int l = it / T_IN, r = it % T_IN, kb = r / 288, nbk = r % 288, n0 = 32 * nbk;
        bf16_t* dst;
        if (n0 < 1024) dst = WTM + ((size_t)l * N_MAIN + n0) * DM;
        else if (n0 < 2048) dst = WTS + ((size_t)l * N_SW + (n0 - 1024)) * DM;
        else if (n0 < 5120) dst = WTM + ((size_t)l * N_MAIN + (n0 - 1024)) * DM;
        else if (n0 < 6144) dst = WTS + ((size_t)l * N_SW + 1024 + (n0 - 5120)) * DM;
        else dst = WTM + ((size_t)l * N_MAIN + (n0 - 2048)) * DM;
        d.W = w_in + (size_t)l * DM * IN_COLS; d.gk = g_norm + l * DM; d.dst = dst; d.N = IN_COLS; d.k0 = 64 * kb; d.n0 = n0; d.K = DM;
    } else {
        const int r0 = it - DEPTH * T_IN, which = r0 / (DEPTH * T_SQ), r1 = r0 % (DEPTH * T_SQ), l = r1 / T_SQ, r = r1 % T_SQ, kb = r / 32, nbk = r % 32;
        d.W = (which == 0 ? w_pa : which == 1 ? w_pb : w_out) + (size_t)l * DM * DM; d.gk = nullptr; d.N = DM; d.k0 = 64 * kb; d.n0 = 32 * nbk;
        if (which == 2) { d.dst = WTO + ((size_t)l * DM + 32 * nbk) * DM; d.K = DM; }
        else { d.dst = WTA + ((size_t)l * DM + 32 * nbk) * 2048 + which * 1024; d.K = 2048; }
    }
    return d;
}
struct Args { const float* in[10]; float* out; unsigned char* ws; int ph_lo, ph_hi; };
constexpr int N_PHASES = 2 + 4 * DEPTH;

__global__ void __launch_bounds__(NWAVES * 64, 2) hyb_fwd(Args args) {
    extern __shared__ __attribute__((aligned(16))) unsigned char lds[];
    LAS unsigned char* L = (LAS unsigned char*)lds;
    const int tid = threadIdx.x, wave = __builtin_amdgcn_readfirstlane(tid >> 6);
#define lane lane_id()
    const int G = gridDim.x, bx = blockIdx.x, vcu = (G % 8 == 0) ? (bx % 8) * (G / 8) + bx / 8 : bx;
    const int gw = vcu * NWAVES + wave, NGW = G * NWAVES;
    const float* x_in = args.in[0]; const float* g_norm = args.in[1]; const float* w_in = args.in[2]; const float* w_s = args.in[3]; const float* b_s = args.in[4];
    const float* g_v = args.in[5]; const float* w_pa = args.in[6]; const float* w_pb = args.in[7]; const float* w_out = args.in[8]; const float* g_final = args.in[9];
#define WS_PTRS() unsigned char* ws = args.ws; asm volatile("" : "+s"(ws)); \
    float* xsq = (float*)(ws + WS_XSQ); float* vsq = (float*)(ws + WS_VSQ); \
    bf16_t* WM = (bf16_t*)(ws + WS_WM); bf16_t* WTM = (bf16_t*)(ws + WS_WT_MAIN); bf16_t* WTS = (bf16_t*)(ws + WS_WT_SW); \
    bf16_t* WTA = (bf16_t*)(ws + WS_WT_A); bf16_t* WTB = (bf16_t*)(ws + WS_WT_B); bf16_t* WTO = (bf16_t*)(ws + WS_WT_O); \
    bf16_t* XB = (bf16_t*)(ws + WS_XB); bf16_t* XBP = (bf16_t*)(ws + WS_XBP); bf16_t* ACT = (bf16_t*)(ws + WS_ACT); \
    bf16_t* GVT = (bf16_t*)(ws + WS_GVT); bf16_t* VT = (bf16_t*)(ws + WS_VT); float* T = (float*)(ws + WS_T); bf16_t* MG = (bf16_t*)(ws + WS_MG); \
    bf16_t* bU = ACT; bf16_t* bAG = ACT + ACT_STRIDE; bf16_t* bQ = ACT + 2 * ACT_STRIDE; bf16_t* bK = ACT + 3 * ACT_STRIDE; bf16_t* bBG = ACT + 4 * ACT_STRIDE; \
    bf16_t* bGA = ACT + 5 * ACT_STRIDE; bf16_t* bGB = ACT + 6 * ACT_STRIDE; \
    (void)xsq; (void)vsq; (void)WM; (void)WTM; (void)WTS; (void)WTA; (void)WTB; (void)WTO; (void)XB; (void)XBP; (void)GVT; (void)VT; (void)T; (void)MG; \
    (void)bU; (void)bAG; (void)bQ; (void)bK; (void)bBG; (void)bGA; (void)bGB
    const int lo = args.ph_lo, hi = args.ph_hi;
#define IN(k) (lo <= (k) && (k) < hi)
#define SEAM(k) do { if (IN(k) && IN((k) + 1)) { xcd_barrier(xbar); } } while (0)

    if (IN(0)) {
        WS_PTRS();
        const int lane0 = lane_id();
        LAS float* scr = (LAS float*)(L + wave * 16384);
        constexpr int T_IN = 16 * 288, T_SQ = 16 * 32, NT = DEPTH * (T_IN + 3 * T_SQ);
#define tile_desc(it) tr_desc((it), w_in, g_norm, w_pa, w_pb, w_out, WTM, WTS, WTA, WTO)
        { TrRegs ra, rb;
          if (gw < NT) tr_load(ra, tile_desc(gw), lane0);
          for (int it = gw; it < NT; it += 2 * NGW) {
              const int it1 = it + NGW, it2 = it + 2 * NGW;
              if (it1 < NT) tr_load(rb, tile_desc(it1), lane0);
              tr_store(ra, tile_desc(it), scr, lane0);
              if (it2 < NT) tr_load(ra, tile_desc(it2), lane0);
              if (it1 < NT) tr_store(rb, tile_desc(it1), scr, lane0);
          } }
#undef tile_desc
        for (int m0 = gw; m0 < M_TOK; m0 += 4 * NGW) {
            f32x4 v[4][4];
#pragma unroll
            for (int rr = 0; rr < 4; ++rr) { const int mrow = m0 + rr * NGW; if (mrow < M_TOK) { const f32x4* xr = (const f32x4*)(x_in + (size_t)mrow * DM) + lane0;
#pragma unroll
                for (int q = 0; q < 4; ++q) v[rr][q] = xr[64 * q]; } }
#pragma unroll
            for (int rr = 0; rr < 4; ++rr) { const int mrow = m0 + rr * NGW; if (mrow < M_TOK) { float s = 0.f;
#pragma unroll
                for (int q = 0; q < 4; ++q) s += (v[rr][q][0] * v[rr][q][0] + v[rr][q][1] * v[rr][q][1]) + (v[rr][q][2] * v[rr][q][2] + v[rr][q][3] * v[rr][q][3]);
                s = wave_sum(s);
                u32x2* o1 = (u32x2*)(XB + (size_t)mrow * DM) + lane0; u32x2* o2 = (u32x2*)(XBP + (size_t)pi_row(mrow) * DM) + lane0;
#pragma unroll
                for (int q = 0; q < 4; ++q) { u32x2 w; w.x = pkbf(v[rr][q][0], v[rr][q][1]); w.y = pkbf(v[rr][q][2], v[rr][q][3]); o1[64 * q] = w; o2[64 * q] = w; }
                if (lane0 == 0) xsq[mrow] = s; } }
        }
        const int gt = vcu * (NWAVES * 64) + tid, NGT = G * NWAVES * 64;
        for (int i = gt; i < 4 * M_TOK; i += NGT) { xsq[M_TOK + i] = 0.f; vsq[i] = 0.f; }
        for (int i = gt; i < XCD_BAR_WORDS; i += NGT) ((unsigned*)(ws + WS_BAR))[i] = 0u;
        for (int i = gt; i < DEPTH * 8 * 128 * 128; i += NGT) { const int sg = i & 127, t = (i >> 7) & 127, s = (sg & 31) * 4 + (sg >> 5);
            const float v = (s <= t) ? w_s[(size_t)(i >> 14) * 16384 + t * 128 + s] : 0.f; WM[i] = (bf16_t)(pkbf(v, 0.f) & 0xffffu); }
    }
    XcdBarrier xbar; xbar.bar = (unsigned*)(args.ws + WS_BAR); xbar.x = 0; xbar.st = (volatile LAS unsigned*)(L + RING_BYTES + 64);
    if (tid < 2) xbar.st[tid] = 0u;
    if (IN(0) && IN(1)) { __threadfence(); cg::this_grid().sync(); }
    if (hi - lo > 1) xbar = xcd_barrier_post((unsigned*)(args.ws + WS_BAR), (volatile LAS unsigned*)(L + RING_BYTES + 64));

    for (int layer = 0; layer < DEPTH; ++layer) {
        const int ph = 1 + 4 * layer;
        if (IN(ph)) {
            WS_PTRS();
            { pg8::Gemm g{XB, WTM + (size_t)layer * N_MAIN * DM, M_TOK, N_MAIN, DM}; pg8::StaticOrder S; S.init(M_TOK, N_MAIN, G, bx);
              EpiMain E{ACT, xsq + layer * M_TOK, MG};
              pg8::gemm_phase<EpiMain, pg8::StaticOrder, true, true>(L, g, S, E);
              if (DUP & 1) pg8::gemm_phase<EpiMain, pg8::StaticOrder, true, true>(L, g, S, E); }
            { pg8::Gemm g{WTS + (size_t)layer * N_SW * DM, XBP, N_SW, M_TOK, DM}; pg8::StaticOrder S; S.init(N_SW, M_TOK, G, bx);
              EpiSw E{GVT, VT, xsq + layer * M_TOK, vsq + layer * M_TOK};
              pg8::gemm_phase<EpiSw, pg8::StaticOrder, true, true>(L, g, S, E); }
        }
        SEAM(ph);
        if (IN(ph + 1)) {
            WS_PTRS(); int ln = lane; asm volatile("" : "+v"(ln));
            MixP p{WM, GVT, VT, (const bf16_t*)MG, bU, bQ, bAG, bBG, vsq + layer * M_TOK, b_s, g_v, (bf16_t*)T, (bf16_t*)T + 1024};
            { int k = 0;
              if (vcu < 1024) gating_stage(p, vcu, L, wave, ln);
              for (int itw = vcu; itw < 1024; itw += G, ++k) {
                  asm volatile("s_waitcnt vmcnt(0)" ::: "memory"); __syncthreads();
                  if (itw + G < 1024) gating_stage(p, itw + G, L + ((k + 1) & 1) * 32768, wave, ln);
                  gating_item(p, layer, itw * 8 + wave, ln, L + (k & 1) * 32768, L + 65536 + wave * 8192);
              }
              __syncthreads(); }
            LAS float* tbl = (LAS float*)(L + RING_BYTES + 1024);
            int vid = vcu;
            if (hi - lo > 1) {
                if (threadIdx.x == 0) { unsigned pre = 0u;
                    for (unsigned jx = 0; jx < 16; ++jx) { const unsigned cx = xb_ld(&xbar.bar[XB_XCNT(jx)]); if (jx < xbar.x) pre += cx; }
                    xbar.st[3] = pre + xbar.st[2]; }
                __syncthreads(); vid = (int)xbar.st[3]; }
            for (int v = vid; v < 256; v += G) {
                const int h = v >> 4, q = (v & 15) * 8 + wave, rho = q & 3, nbsel = (q >> 2) & 15;
                __syncthreads(); build_bias_table(tbl, h, tid); __syncthreads();
                for (int r = 0; r < 4; ++r) {
                    if (DUP & 8) { MixP pd = p; pd.QO = MG; attn_item(pd, tbl, 2 * r + (q >> 6), h, (r & 1) ? 15 - nbsel : nbsel, rho, ln); }
                    attn_item(p, tbl, 2 * r + (q >> 6), h, (r & 1) ? 15 - nbsel : nbsel, rho, ln); }
            }
            __syncthreads();
        }
        SEAM(ph + 1);
        if (IN(ph + 2)) {
            WS_PTRS();
            pg8::Gemm g{(const bf16_t*)T, WTA + (size_t)layer * DM * 2048, M_TOK, DM, 2048}; pg8::StaticOrder S; S.init(M_TOK, DM, G, bx);
            EpiMerge2 E{bGA, bGB, MG}; pg8::gemm_phase<EpiMerge2, pg8::StaticOrder, true, true>(L, g, S, E);
        }
        SEAM(ph + 2);
        if (IN(ph + 3)) {
            WS_PTRS();
            pg8::Gemm g{MG, WTO + (size_t)layer * DM * DM, M_TOK, DM, DM}; pg8::StaticOrder S; S.init(M_TOK, DM, G, bx);
            EpiOut E{layer == 0 ? x_in : args.out, args.out, XB, XBP, xsq + (layer + 1) * M_TOK};
            pg8::gemm_phase<EpiOut, pg8::StaticOrder, true, true>(L, g, S, E);
        }
        SEAM(ph + 3);
    }
    if (IN(N_PHASES - 1)) {
        WS_PTRS();
        const float* fs = xsq + DEPTH * M_TOK; const int lane1 = lane_id();
        f32x4 gq[4];
#pragma unroll
        for (int q = 0; q < 4; ++q) gq[q] = *((const f32x4*)g_final + lane1 + 64 * q);
        for (int m0 = gw; m0 < M_TOK; m0 += 4 * NGW) {
            f32x4 v[4][4]; float rs[4];
#pragma unroll
            for (int rr = 0; rr < 4; ++rr) { const int mrow = m0 + rr * NGW; if (mrow < M_TOK) { rs[rr] = fs[mrow]; const f32x4* xr = (const f32x4*)(args.out + (size_t)mrow * DM) + lane1;
#pragma unroll
                for (int q = 0; q < 4; ++q) v[rr][q] = xr[64 * q]; } }
#pragma unroll
            for (int rr = 0; rr < 4; ++rr) { const int mrow = m0 + rr * NGW; if (mrow < M_TOK) { const float r_ = rs_of(rs[rr]); f32x4* xr = (f32x4*)(args.out + (size_t)mrow * DM) + lane1;
#pragma unroll
                for (int q = 0; q < 4; ++q) xr[64 * q] = v[rr][q] * r_ * gq[q]; } }
        }
    }
#undef IN
#undef SEAM
#undef WS_PTRS
#undef lane
}


extern "C" void kernel_launch(void* const* d_in, const int* in_sizes, int n_in, void* d_out, int out_size, void* d_ws, size_t ws_size, hipStream_t stream) {
    static int grid = 0;
    if (grid == 0) {
        if (n_in != 10 || in_sizes[0] != M_TOK * DM || out_size != M_TOK * DM || ws_size < WS_END) { fprintf(stderr, "kernel_launch: unexpected shapes / workspace (%d inputs, ws %zu, need %zu)\n", n_in, ws_size, (size_t)WS_END); grid = -1; return; }
        int dev = 0, cus = 0, per_cu = 0;
        (void)hipGetDevice(&dev); (void)hipDeviceGetAttribute(&cus, hipDeviceAttributeMultiprocessorCount, dev);
        if (hipFuncSetAttribute((const void*)hyb_fwd, hipFuncAttributeMaxDynamicSharedMemorySize, LDS_BYTES) != hipSuccess) { fprintf(stderr, "kernel_launch: hipFuncSetAttribute failed\n"); grid = -1; return; }
        if (hipOccupancyMaxActiveBlocksPerMultiprocessor(&per_cu, (const void*)hyb_fwd, NWAVES * 64, LDS_BYTES) != hipSuccess || per_cu != 1) per_cu = 1;
        (void)hipGetLastError();
        if (cus <= 0) cus = 256;
        grid = cus * per_cu;
    }
    if (grid < 0) return;
    Args a{};
    for (int i = 0; i < 10; ++i) a.in[i] = (const float*)d_in[i];
    a.out = (float*)d_out; a.ws = (unsigned char*)d_ws;
#if MK_MULTI
    for (int ph = 0; ph < N_PHASES; ++ph) { a.ph_lo = ph; a.ph_hi = ph + 1; hipLaunchKernelGGL(hyb_fwd, dim3(grid), dim3(NWAVES * 64), LDS_BYTES, stream, a); }
#else
    a.ph_lo = 0; a.ph_hi = N_PHASES;
    void* kargs[] = {&a};
    hipError_t e = hipLaunchCooperativeKernel((const void*)hyb_fwd, dim3(grid), dim3(NWAVES * 64), kargs, LDS_BYTES, stream);
    if (e != hipSuccess) fprintf(stderr, "kernel_launch: cooperative launch failed: %s (grid %d)\n", hipGetErrorString(e), grid);
#endif
}
```

```cpp
#include <hip/hip_runtime.h>
#include <hip/hip_cooperative_groups.h>
#include <cstdio>
#include <cstdint>
namespace cg = cooperative_groups;
#ifndef DUP
#define DUP 0
#endif
#ifndef MK_MULTI
#define MK_MULTI 0
#endif
namespace pg8 {
#define PG8_LAS __attribute__((address_space(3)))
typedef unsigned short bf16_t;
typedef short bf16x8 __attribute__((ext_vector_type(8)));
typedef float f32x4 __attribute__((ext_vector_type(4)));
typedef unsigned u32x4 __attribute__((ext_vector_type(4)));
constexpr int BM = 256, BK = 64, HALF = 128, HTB = HALF * BK * 2  , STAGE_BYTES = 8 * HTB, NXCD = 8, WGM = 8;

__host__ __device__ __forceinline__ int lds_byte(int r, int c) { const int st = (r >> 4) * 2 + (c >> 5), rr = r & 15, cc = c & 31, ob = rr * 64 + cc * 2; return st * 1024 + (ob ^ (((ob >> 9) & 1) << 5)); }
__host__ __device__ __forceinline__ void stage_rc(int b, int& R, int& C) { const int st = b / 1024, sb = b % 1024, swz = sb ^ (((sb >> 9) & 1) << 5); R = (st >> 1) * 16 + swz / 64; C = (st & 1) * 32 + (swz % 64) / 2; }
__host__ __device__ __forceinline__ int perm32(int rho) { const int n = rho >> 4, i = rho & 15; return 8 * (i >> 2) + 4 * n + (i & 3); }

struct Unit { int pm, pn; };
struct Gemm { const bf16_t* A; const bf16_t* Bt; int M, N, K; int bpi; };

struct StaticOrder {
    int nM, nN, nwg, G, c;
    __host__ __device__ void init(int M, int N, int G_, int c_) { nM = M / BM; nN = N / BM; nwg = nM * nN; G = G_; c = c_; }
    __host__ __device__ bool next(int i, Unit& u) const {
        const long L = (long)i * G + c; if (L >= nwg) return false;
        int wgid = (int)L; { const int q = nwg / NXCD, r = nwg % NXCD, xcd = wgid % NXCD, off = wgid / NXCD; wgid = (xcd < r ? xcd * (q + 1) : r * (q + 1) + (xcd - r) * q) + off; }
        const int nig = WGM * nN, gid = wgid / nig, fm = gid * WGM, gsz = (nM - fm) < WGM ? (nM - fm) : WGM;
        u.pm = fm + ((wgid % nig) % gsz); u.pn = (wgid % nig) / gsz; return true;
    }
    __device__ __forceinline__ void a_ready(const Unit&) const {}
    __device__ __forceinline__ void done(const Unit&) const {}
};
__device__ __forceinline__ unsigned cvt_pk_bf16(float lo, float hi) { unsigned r; asm volatile("v_cvt_pk_bf16_f32 %0, %1, %2" : "=v"(r) : "v"(lo), "v"(hi)); return r; }
template <class Epi, class Sched, bool ALIGN_EPI = false, bool SP2 = false>
__device__ __forceinline__ void gemm_phase(PG8_LAS unsigned char* lds, const Gemm g, const Sched& S, const Epi& E) {
    int tid = threadIdx.x; asm volatile("" : "+v"(tid));
    const int wid = __builtin_amdgcn_readfirstlane(tid >> 6), lane = tid & 63, wr = wid >> 2, wc = wid & 3, fr = lane & 15, fq = lane >> 4;
    const int K = g.K, nt = K / BK;
    const int brs = g.bpi ? 4 : 1;
    unsigned voffA[2], voffB[2];
#pragma unroll
    for (int i = 0; i < 2; ++i) { int R, C; stage_rc(tid * 16 + i * 8192, R, C); const int Rb = Epi::PERM ? ((R & ~31) + perm32(R & 31)) : R;
        voffA[i] = (unsigned)(R * K + C) * 2u; voffB[i] = (unsigned)(Rb * brs * K + C) * 2u; }
    const size_t kstep = (size_t)(BK * 2);
    const size_t hstep = (size_t)HALF * K * 2;
    const size_t tstep = 2 * hstep;
    const size_t hstepB = hstep * brs;
#define PG8_BBASE(pn) ((const char*)g.Bt + (g.bpi ? (size_t)((((pn) * 256) & ~2047) | ((((pn) * 256) & 511) << 2) | ((((pn) * 256) >> 9) & 3)) * (size_t)(K * 2) : (size_t)(pn) * tstep))
    const unsigned ldsw = (unsigned)wid * 1024u;
    const int aoff = lds_byte(wr * 64 + fr, fq * 8), boff = lds_byte(wc * 32 + fr, fq * 8);
#define PG8_SA(b, h) (((b) * 2 + (h)) * HTB)
#define PG8_SB(b, h) ((4 + (b) * 2 + (h)) * HTB)
#define PG8_STAGE(bufoff, gbase, voff) do { _Pragma("unroll") for (int _i = 0; _i < 2; ++_i) \
        __builtin_amdgcn_global_load_lds((const unsigned*)((const char*)(gbase) + (voff)[_i]), (PG8_LAS unsigned*)(lds + (bufoff) + ldsw + _i * 8192), 16, 0, 0); } while (0)
#define PG8_LDA(dst, b, h) do { _Pragma("unroll") for (int m = 0; m < 4; ++m) _Pragma("unroll") for (int k = 0; k < 2; ++k) dst[m][k] = *(const PG8_LAS bf16x8*)(lds + PG8_SA(b, h) + aoff + m * 2048 + k * 1024); } while (0)
#define PG8_LDB(dst, b, h) do { _Pragma("unroll") for (int n = 0; n < 2; ++n) _Pragma("unroll") for (int k = 0; k < 2; ++k) dst[n][k] = *(const PG8_LAS bf16x8*)(lds + PG8_SB(b, h) + boff + n * 2048 + k * 1024); } while (0)
#define PG8_MMA(ai, bj, At, Bt) do { __builtin_amdgcn_s_setprio(1); _Pragma("unroll") for (int m = 0; m < 4; ++m) _Pragma("unroll") for (int n = 0; n < 2; ++n) _Pragma("unroll") for (int k = 0; k < 2; ++k) \
        acc[ai][bj][m][n] = __builtin_amdgcn_mfma_f32_16x16x32_bf16(Bt[n][k], At[m][k], acc[ai][bj][m][n], 0, 0, 0); __builtin_amdgcn_s_setprio(0); } while (0)
#define PG8_WAIT_V(n) asm volatile("s_waitcnt vmcnt(" #n ")" ::: "memory")
#define PG8_WAIT_L(n) asm volatile("s_waitcnt lgkmcnt(" #n ")" ::: "memory")
#define PG8_BAR __builtin_amdgcn_s_barrier()
#define PG8_SCHED __builtin_amdgcn_sched_barrier(0)
    Unit cur, nxt; int ui = 0;
    if (!S.next(0, cur)) return;
    f32x4 acc[2][2][4][2];
#pragma unroll
    for (int a = 0; a < 2; ++a)
#pragma unroll
        for (int b = 0; b < 2; ++b)
#pragma unroll
            for (int m = 0; m < 4; ++m)
#pragma unroll
                for (int n = 0; n < 2; ++n) acc[a][b][m][n] = (f32x4){0.f, 0.f, 0.f, 0.f};
    bf16x8 At[4][2], B0[2][2], B1[2][2];
    const char* cA = (const char*)g.A + (size_t)cur.pm * tstep; const char* cB = PG8_BBASE(cur.pn);
    S.a_ready(cur);
    if constexpr (SP2) {
        PG8_STAGE(PG8_SB(0, 0), cB, voffB); PG8_STAGE(PG8_SB(0, 1), cB + hstepB, voffB); PG8_STAGE(PG8_SA(0, 0), cA, voffA); PG8_STAGE(PG8_SA(0, 1), cA + hstep, voffA);
        if (wr == 1) PG8_BAR;
        PG8_WAIT_V(2); PG8_BAR;
        PG8_STAGE(PG8_SB(1, 0), cB + kstep, voffB); PG8_STAGE(PG8_SA(1, 0), cA + kstep, voffA); PG8_STAGE(PG8_SB(1, 1), cB + hstepB + kstep, voffB);
        PG8_WAIT_V(6); PG8_BAR;
    } else {
        PG8_STAGE(PG8_SB(0, 0), cB, voffB); PG8_STAGE(PG8_SA(0, 0), cA, voffA); PG8_STAGE(PG8_SB(0, 1), cB + hstepB, voffB); PG8_STAGE(PG8_SA(0, 1), cA + hstep, voffA);
        if (wr == 1) PG8_BAR;
        PG8_WAIT_V(4); PG8_BAR;
        PG8_STAGE(PG8_SB(1, 0), cB + kstep, voffB); PG8_STAGE(PG8_SA(1, 0), cA + kstep, voffA); PG8_STAGE(PG8_SB(1, 1), cB + hstepB + kstep, voffB);
        PG8_WAIT_V(6); PG8_BAR;
    }
    for (;;) {
        const bool has_next = S.next(ui + 1, nxt);
        const char* nA = has_next ? (const char*)g.A + (size_t)nxt.pm * tstep : cA; const char* nB = has_next ? PG8_BBASE(nxt.pn) : cB;
        for (int t = 0; t < nt; t += 2) {
            if constexpr (Epi::MIDK) { if (t == nt / 2) E.mid(acc, cur, wr, wc, fr, fq); }
            const bool last = (t == nt - 2);
            const char* a1 = cA + (size_t)(t + 1) * kstep;
            const char* a2 = last ? nA : cA + (size_t)(t + 2) * kstep; const char* b2 = last ? nB : cB + (size_t)(t + 2) * kstep;
            const char* a3 = a2 + kstep; const char* b3 = b2 + kstep;
            if (last && has_next) S.a_ready(nxt);
            if constexpr (SP2) {
            PG8_LDB(B0, 0, 0); PG8_LDB(B1, 0, 1); PG8_SCHED; PG8_LDA(At, 0, 0); PG8_STAGE(PG8_SA(1, 1), a1 + hstep, voffA);
            PG8_WAIT_V(8); PG8_WAIT_L(0); PG8_BAR; PG8_MMA(0, 0, At, B0); PG8_MMA(0, 1, At, B1); PG8_BAR; PG8_SCHED;
            PG8_LDA(At, 0, 1); PG8_STAGE(PG8_SB(0, 0), b2, voffB); PG8_STAGE(PG8_SB(0, 1), b2 + hstepB, voffB); PG8_STAGE(PG8_SA(0, 0), a2, voffA);
            PG8_WAIT_V(8); PG8_WAIT_L(0); PG8_BAR; PG8_MMA(1, 0, At, B0); PG8_MMA(1, 1, At, B1); PG8_BAR; PG8_SCHED;
            PG8_LDB(B0, 1, 0); PG8_LDB(B1, 1, 1); PG8_SCHED; PG8_LDA(At, 1, 0); PG8_STAGE(PG8_SA(0, 1), a2 + hstep, voffA);
            PG8_WAIT_V(8); PG8_WAIT_L(0); PG8_BAR; PG8_MMA(0, 0, At, B0); PG8_MMA(0, 1, At, B1); PG8_BAR; PG8_SCHED;
            PG8_LDA(At, 1, 1); PG8_STAGE(PG8_SB(1, 0), b3, voffB); PG8_STAGE(PG8_SB(1, 1), b3 + hstepB, voffB); PG8_STAGE(PG8_SA(1, 0), a3, voffA);
            PG8_WAIT_V(8); PG8_WAIT_L(0); PG8_BAR; PG8_MMA(1, 0, At, B0); PG8_MMA(1, 1, At, B1); PG8_BAR; PG8_SCHED;
            } else {
            PG8_LDB(B0, 0, 0); PG8_SCHED; PG8_LDA(At, 0, 0); PG8_STAGE(PG8_SA(1, 1), a1 + hstep, voffA);
            PG8_WAIT_L(8); PG8_BAR; PG8_WAIT_L(0); PG8_MMA(0, 0, At, B0); PG8_BAR; PG8_SCHED;
            PG8_LDB(B1, 0, 1); PG8_STAGE(PG8_SB(0, 0), b2, voffB);
            PG8_BAR; PG8_WAIT_L(0); PG8_MMA(0, 1, At, B1); PG8_BAR;
            PG8_LDA(At, 0, 1); PG8_STAGE(PG8_SA(0, 0), a2, voffA);
            PG8_BAR; PG8_WAIT_L(0); PG8_MMA(1, 0, At, B0); PG8_BAR; PG8_SCHED;
            PG8_STAGE(PG8_SB(0, 1), b2 + hstepB, voffB);
            PG8_WAIT_V(6); PG8_BAR; PG8_MMA(1, 1, At, B1); PG8_BAR;
            PG8_LDB(B0, 1, 0); PG8_SCHED; PG8_LDA(At, 1, 0); PG8_STAGE(PG8_SA(0, 1), a2 + hstep, voffA);
            PG8_WAIT_L(8); PG8_BAR; PG8_WAIT_L(0); PG8_MMA(0, 0, At, B0); PG8_BAR; PG8_SCHED;
            PG8_LDB(B1, 1, 1); PG8_STAGE(PG8_SB(1, 0), b3, voffB);
            PG8_BAR; PG8_WAIT_L(0); PG8_MMA(0, 1, At, B1); PG8_BAR;
            PG8_LDA(At, 1, 1); PG8_STAGE(PG8_SA(1, 0), a3, voffA);
            PG8_BAR; PG8_WAIT_L(0); PG8_MMA(1, 0, At, B0); PG8_BAR; PG8_SCHED;
            PG8_STAGE(PG8_SB(1, 1), b3 + hstepB, voffB);
            PG8_WAIT_V(6); PG8_BAR; PG8_MMA(1, 1, At, B1); PG8_BAR;
            }
        }
        if constexpr (ALIGN_EPI) { if (wr == 0) PG8_BAR; }
        if constexpr (!Epi::AFTER_DRAIN) { E(acc, cur, wr, wc, fr, fq); S.done(cur); }
        if (!has_next) break;
#pragma unroll
        for (int a = 0; a < 2; ++a)
#pragma unroll
            for (int b = 0; b < 2; ++b)
#pragma unroll
                for (int m = 0; m < 4; ++m)
#pragma unroll
                    for (int n = 0; n < 2; ++n) acc[a][b][m][n] = (f32x4){0.f, 0.f, 0.f, 0.f};
        cur = nxt; cA = nA; cB = nB; ++ui;
        if constexpr (ALIGN_EPI) { if (wr == 1) PG8_BAR; }
    }
    PG8_WAIT_V(0);
    if constexpr (!ALIGN_EPI) { if (wr == 0) PG8_BAR; }
    PG8_BAR;
    if constexpr (Epi::AFTER_DRAIN) { E.fused(acc, cur, wr, wc, fr, fq, lds, wid, lane); S.done(cur); }
#undef PG8_SA
#undef PG8_BBASE
#undef PG8_SB
#undef PG8_STAGE
#undef PG8_LDA
#undef PG8_LDB
#undef PG8_MMA
#undef PG8_WAIT_V
#undef PG8_WAIT_L
#undef PG8_BAR
#undef PG8_SCHED
}
}
using pg8::bf16_t; using pg8::bf16x8; using pg8::f32x4; using pg8::u32x4;
typedef unsigned u32x2 __attribute__((ext_vector_type(2)));
constexpr int NWAVES = 8;
constexpr int M_TOK = 16384, DM = 1024, SEQ = 2048, DEPTH = 4, IN_COLS = 9216;
constexpr int N_MAIN = 7168, N_SW = 2048;
constexpr float EPS = 1e-6f;
constexpr float LOG2E = 1.4426950408889634f;
constexpr float QSCALE = 0.125f * LOG2E;
constexpr size_t MiB = 1u << 20;
constexpr size_t WS_XSQ = 0;
constexpr size_t WS_VSQ = 512 * 1024;
constexpr size_t WS_BAR = 768 * 1024;
constexpr size_t WS_WM = 1 * MiB;
constexpr size_t WS_WT_MAIN = 2 * MiB;
constexpr size_t WS_WT_SW = 58 * MiB;
constexpr size_t WS_WT_A = 74 * MiB, WS_WT_B = 82 * MiB, WS_WT_O = 90 * MiB;
constexpr size_t WS_XB = 98 * MiB, WS_XBP = 130 * MiB;
constexpr size_t WS_ACT = 162 * MiB;
constexpr size_t ACT_STRIDE = (size_t)M_TOK * DM;
constexpr int P_T = M_TOK + 64;
constexpr int P_K = DM + 64;
constexpr size_t WS_GVT = 386 * MiB, WS_VT = 419 * MiB;
constexpr size_t WS_T = 452 * MiB;
constexpr size_t WS_MG = 516 * MiB;
constexpr size_t WS_END = 550 * MiB;
constexpr int RING_BYTES = 131072, LDS_BYTES = 147456;

#define GAS __attribute__((address_space(1)))
#define LAS __attribute__((address_space(3)))

__device__ __forceinline__ float bf2f(unsigned short h) { return __builtin_bit_cast(float, (unsigned)h << 16); }
__device__ __forceinline__ float bflo(unsigned w) { return __builtin_bit_cast(float, w << 16); }
__device__ __forceinline__ float bfhi(unsigned w) { return __builtin_bit_cast(float, w & 0xffff0000u); }
__device__ __forceinline__ unsigned pkbf(float lo, float hi) { return pg8::cvt_pk_bf16(lo, hi); }
__device__ __forceinline__ float sigm(float z) { return __builtin_amdgcn_rcpf(1.f + __builtin_amdgcn_exp2f(-LOG2E * z)); }
__device__ __forceinline__ float gelu_t(float v) { const float z = 1.5957691216057308f * v * (1.f + 0.044715f * v * v); return v * sigm(z); }
__device__ __forceinline__ float rs_of(float ss) { return __builtin_amdgcn_rsqf(ss * (1.0f / 1024.0f) + EPS); }
__device__ __forceinline__ int pi_row(int row) { return (row & ~2047) | ((row & 3) << 9) | ((row & 2047) >> 2); }
__device__ __forceinline__ int pi_inv(int p) { return (p & ~2047) | ((p & 511) << 2) | ((p >> 9) & 3); }

__device__ __forceinline__ size_t cm_off(int p, int chan) { return ((size_t)((((p >> 11) * 4 + ((p >> 9) & 3)) * 16 + ((p >> 5) & 15)) * 1024 + chan)) * 32 + (p & 31); }
__device__ __forceinline__ size_t kb_off(int row, int col) { const int b = row >> 11, tl = row & 2047; return (size_t)(((((b * 16 + (col >> 6)) * 4 + (tl & 3)) * 16 + (tl >> 7)) * 32 + ((tl >> 2) & 31))) * 64 + (col & 63); }
struct EpiMain {
    static constexpr bool PERM = true, AFTER_DRAIN = false, MIDK = false;
    bf16_t* O; const float* xsq; bf16_t* KB;
    __device__ __forceinline__ void operator()(const f32x4 (&acc)[2][2][4][2], const pg8::Unit& u, int wr, int wc, int fr, int fq) const {
        asm volatile("" : "+v"(fr), "+v"(fq));
        const int seg = u.pn >> 2;
        bf16_t* base = O + (size_t)seg * ACT_STRIDE;
        const int col0 = (u.pn & 3) * 256 + wc * 32 + 8 * fq, row0 = u.pm * 256 + wr * 64 + fr;
        const float lin = seg == 2 ? QSCALE : 1.f;
#pragma unroll
        for (int ai = 0; ai < 2; ++ai)
#pragma unroll
            for (int m = 0; m < 4; ++m) { const int row = row0 + ai * 128 + m * 16; const float rs = rs_of(xsq[row]); const float rl = rs * lin; bf16_t* rowp = seg == 3 ? KB + kb_off(row, col0) : base + (size_t)row * DM + col0;
#pragma unroll
                for (int bj = 0; bj < 2; ++bj) { float v[8];
                    if (seg >= 5) {
#pragma unroll
                        for (int e = 0; e < 4; ++e) { v[e] = sigm(acc[ai][bj][m][0][e] * rs); v[4 + e] = sigm(acc[ai][bj][m][1][e] * rs); }
                    } else {
#pragma unroll
                        for (int e = 0; e < 4; ++e) { v[e] = acc[ai][bj][m][0][e] * rl; v[4 + e] = acc[ai][bj][m][1][e] * rl; }
                    }
                    u32x4 w; w.x = pkbf(v[0], v[1]); w.y = pkbf(v[2], v[3]); w.z = pkbf(v[4], v[5]); w.w = pkbf(v[6], v[7]);
                    *(u32x4*)(rowp + (seg == 3 ? 2 * 32 * 16 * 4 * 64 * bj : 128 * bj)) = w; } }
    }
};
struct EpiSw {
    static constexpr bool PERM = true, AFTER_DRAIN = false, MIDK = false;
    bf16_t* GVT; bf16_t* VT; const float* xsq; float* vsq;
    __device__ __forceinline__ void operator()(const f32x4 (&acc)[2][2][4][2], const pg8::Unit& u, int wr, int wc, int fr, int fq) const {
        asm volatile("" : "+v"(fr), "+v"(fq));
        const int colbase = u.pn * 256 + wc * 32 + 8 * fq;
        float cs[2][8];
#pragma unroll
        for (int bj = 0; bj < 2; ++bj)
#pragma unroll
            for (int e = 0; e < 8; ++e) cs[bj][e] = rs_of(xsq[pi_inv(colbase + bj * 128 + e)]);
        const bool isv = u.pm >= 4;
        bf16_t* out = isv ? VT : GVT; const int chan0 = (isv ? u.pm - 4 : u.pm) * 256;
        const int row0 = wr * 64 + fr;
        float ss[2][8];
#pragma unroll
        for (int bj = 0; bj < 2; ++bj)
#pragma unroll
            for (int e = 0; e < 8; ++e) ss[bj][e] = 0.f;
#pragma unroll
        for (int ai = 0; ai < 2; ++ai)
#pragma unroll
            for (int m = 0; m < 4; ++m) { bf16_t* rowp = out + cm_off(colbase, chan0 + row0 + ai * 128 + m * 16);
#pragma unroll
                for (int bj = 0; bj < 2; ++bj) { float v[8];
#pragma unroll
                    for (int e = 0; e < 4; ++e) { v[e] = acc[ai][bj][m][0][e] * cs[bj][e]; v[4 + e] = acc[ai][bj][m][1][e] * cs[bj][4 + e]; }
                    if (!isv) {
#pragma unroll
                        for (int e = 0; e < 8; ++e) { v[e] = gelu_t(v[e]); ss[bj][e] += v[e] * v[e]; } }
                    u32x4 w; w.x = pkbf(v[0], v[1]); w.y = pkbf(v[2], v[3]); w.z = pkbf(v[4], v[5]); w.w = pkbf(v[6], v[7]);
                    *(u32x4*)(rowp + bj * 4 * 1024 * 32) = w; } }
        if (!isv) {
            float mine = 0.f;
#pragma unroll
            for (int bj = 0; bj < 2; ++bj)
#pragma unroll
                for (int e = 0; e < 8; ++e) { float s = ss[bj][e];
                    s += __shfl_xor(s, 1); s += __shfl_xor(s, 2); s += __shfl_xor(s, 4); s += __shfl_xor(s, 8);
                    if (fr == bj * 8 + e) mine = s; }
            atomicAdd(vsq + colbase + (fr >> 3) * 128 + (fr & 7), mine);
        }
    }
};
struct EpiMerge2 {
    static constexpr bool PERM = true, AFTER_DRAIN = false, MIDK = true;
    const bf16_t* GA; const bf16_t* GB; bf16_t* MG;
    __device__ __forceinline__ void mid(f32x4 (&acc)[2][2][4][2], const pg8::Unit& u, int wr, int wc, int fr, int fq) const {
        asm volatile("" : "+v"(fr), "+v"(fq));
        const int col0 = u.pn * 256 + wc * 32 + 8 * fq, row0 = u.pm * 256 + wr * 64 + fr;
#pragma unroll
        for (int ai = 0; ai < 2; ++ai)
#pragma unroll
            for (int m = 0; m < 4; ++m)
#pragma unroll
                for (int bj = 0; bj < 2; ++bj) { const size_t off = (size_t)(row0 + ai * 128 + m * 16) * DM + col0 + bj * 128;
                    const u32x4 ga = *(const u32x4*)(GA + off), gb = *(const u32x4*)(GB + off);
                    f32x4 r0, r1;
                    r0[0] = bflo(ga.x) * __builtin_amdgcn_rcpf(bflo(gb.x)); r0[1] = bfhi(ga.x) * __builtin_amdgcn_rcpf(bfhi(gb.x)); r0[2] = bflo(ga.y) * __builtin_amdgcn_rcpf(bflo(gb.y)); r0[3] = bfhi(ga.y) * __builtin_amdgcn_rcpf(bfhi(gb.y));
                    r1[0] = bflo(ga.z) * __builtin_amdgcn_rcpf(bflo(gb.z)); r1[1] = bfhi(ga.z) * __builtin_amdgcn_rcpf(bfhi(gb.z)); r1[2] = bflo(ga.w) * __builtin_amdgcn_rcpf(bflo(gb.w)); r1[3] = bfhi(ga.w) * __builtin_amdgcn_rcpf(bfhi(gb.w));
                    acc[ai][bj][m][0] = acc[ai][bj][m][0] * r0; acc[ai][bj][m][1] = acc[ai][bj][m][1] * r1; }
    }
    __device__ __forceinline__ void operator()(const f32x4 (&acc)[2][2][4][2], const pg8::Unit& u, int wr, int wc, int fr, int fq) const {
        asm volatile("" : "+v"(fr), "+v"(fq));
        const int col0 = u.pn * 256 + wc * 32 + 8 * fq, row0 = u.pm * 256 + wr * 64 + fr;
#pragma unroll
        for (int ai = 0; ai < 2; ++ai)
#pragma unroll
            for (int m = 0; m < 4; ++m)
#pragma unroll
                for (int bj = 0; bj < 2; ++bj) { const size_t off = (size_t)(row0 + ai * 128 + m * 16) * DM + col0 + bj * 128;
                    const u32x4 g = *(const u32x4*)(GB + off);
                    f32x4 a, b; a[0] = bflo(g.x); a[1] = bfhi(g.x); a[2] = bflo(g.y); a[3] = bfhi(g.y); b[0] = bflo(g.z); b[1] = bfhi(g.z); b[2] = bflo(g.w); b[3] = bfhi(g.w);
                    const f32x4 r0 = a * acc[ai][bj][m][0], r1 = b * acc[ai][bj][m][1];
                    u32x4 w; w.x = pkbf(r0[0], r0[1]); w.y = pkbf(r0[2], r0[3]); w.z = pkbf(r1[0], r1[1]); w.w = pkbf(r1[2], r1[3]);
                    *(u32x4*)(MG + off) = w; }
    }
};
struct EpiOut {
    static constexpr bool PERM = true, AFTER_DRAIN = false, MIDK = false;
    const float* xin; float* xout; bf16_t* xb; bf16_t* xbp; float* xsq_next;
    __device__ __forceinline__ void operator()(const f32x4 (&acc)[2][2][4][2], const pg8::Unit& u, int wr, int wc, int fr, int fq) const {
        asm volatile("" : "+v"(fr), "+v"(fq));
        const int col0 = u.pn * 256 + wc * 32 + 8 * fq, row0 = u.pm * 256 + wr * 64 + fr;
#pragma unroll
        for (int ai = 0; ai < 2; ++ai)
#pragma unroll
            for (int m = 0; m < 4; ++m) { const int row = row0 + ai * 128 + m * 16; float ss = 0.f;
#pragma unroll
                for (int bj = 0; bj < 2; ++bj) { const size_t off = (size_t)row * DM + col0 + bj * 128;
                    const f32x4 r0 = *(const f32x4*)(xin + off) + acc[ai][bj][m][0], r1 = *(const f32x4*)(xin + off + 4) + acc[ai][bj][m][1];
                    *(f32x4*)(xout + off) = r0; *(f32x4*)(xout + off + 4) = r1;
                    ss += (r0[0] * r0[0] + r0[1] * r0[1]) + (r0[2] * r0[2] + r0[3] * r0[3]) + (r1[0] * r1[0] + r1[1] * r1[1]) + (r1[2] * r1[2] + r1[3] * r1[3]);
                    u32x4 w; w.x = pkbf(r0[0], r0[1]); w.y = pkbf(r0[2], r0[3]); w.z = pkbf(r1[0], r1[1]); w.w = pkbf(r1[2], r1[3]);
                    *(u32x4*)(xb + off) = w; }
                ss += __shfl_xor(ss, 16); ss += __shfl_xor(ss, 32);
                if (fq == 0) atomicAdd(xsq_next + row, ss); }
    }
};
struct MixP { const bf16_t* WM; const bf16_t* GVT; const bf16_t* VT; const bf16_t* K; bf16_t* U; bf16_t* Q; const bf16_t* AG; const bf16_t* BG; const float* vsq; const float* b_s; const float* g_v; bf16_t* UO; bf16_t* QO; };
#define MFMA16(a, b, c) __builtin_amdgcn_mfma_f32_16x16x32_bf16((a), (b), (c), 0, 0, 0)

__device__ __forceinline__ void gating_stage(const MixP& p, int itw, LAS unsigned char* buf, int wave, int lane) {
    const int g = itw & 7, c = (itw >> 3) & 15, b = itw >> 7, r16 = lane >> 2, pp = lane & 3;
#pragma unroll
    for (int q = 0; q < 4; ++q) { const int chunk = wave * 4 + q, dt = chunk >> 2, ks = chunk & 3;
        const bf16_t* src = p.GVT + ((size_t)(((b * 4 + ks) * 16 + c) * 1024 + g * 128 + 16 * dt + r16)) * 32 + 8 * (pp ^ ((r16 >> 2) & 3));
        __builtin_amdgcn_global_load_lds((const unsigned*)src, (LAS unsigned*)(buf + chunk * 1024), 16, 0, 0); }
}
__device__ __forceinline__ void gating_item(const MixP& p, int layer, int it, int lane, const LAS unsigned char* tile, LAS unsigned char* io) {
    const int tt = it & 7, g = (it >> 3) & 7, c = (it >> 6) & 15, b = it >> 10;
    const int j = lane & 15, kg = lane >> 4;
    const bf16_t* wm = p.WM + ((size_t)((layer * 8 + g) * 128 + 16 * tt + j)) * 128 + 8 * kg;
    const size_t tok0 = (size_t)b * 2048 + 128 * c + 16 * tt;
    { const int rr = lane >> 4, pos = lane & 15;
#pragma unroll
      for (int q = 0; q < 4; ++q) { const int row = 4 * q + rr; const size_t off = (tok0 + row) * DM + g * 128 + 8 * (pos ^ row);
          __builtin_amdgcn_global_load_lds((const unsigned*)(p.U + off), (LAS unsigned*)(io + q * 1024), 16, 0, 0);
          __builtin_amdgcn_global_load_lds((const unsigned*)(p.AG + off), (LAS unsigned*)(io + 4096 + q * 1024), 16, 0, 0); } }
    const int t = 16 * tt + j;
    const float bias = p.b_s[(layer * 8 + g) * 128 + t];
    f32x4 acc[8];
#pragma unroll
    for (int dt = 0; dt < 8; ++dt) acc[dt] = (f32x4){0.f, 0.f, 0.f, 0.f};
    bf16x8 bfr[4];
#pragma unroll
    for (int ks = 0; ks < 4; ++ks) {
        const int pb = b * 2048 + ks * 512 + 32 * c + 8 * kg;
        const u32x4 wraw = *(const u32x4*)(wm + 32 * ks);
        const f32x4 q0 = *(const f32x4*)(p.vsq + pb), q1 = *(const f32x4*)(p.vsq + pb + 4);
        u32x4 bw;
        bw.x = pkbf(bflo(wraw.x) * rs_of(q0[0]), bfhi(wraw.x) * rs_of(q0[1])); bw.y = pkbf(bflo(wraw.y) * rs_of(q0[2]), bfhi(wraw.y) * rs_of(q0[3]));
        bw.z = pkbf(bflo(wraw.z) * rs_of(q1[0]), bfhi(wraw.z) * rs_of(q1[1])); bw.w = pkbf(bflo(wraw.w) * rs_of(q1[2]), bfhi(wraw.w) * rs_of(q1[3]));
        bfr[ks] = __builtin_bit_cast(bf16x8, bw);
    }
#pragma unroll
    for (int ks = 0; ks < 4; ++ks) {
#pragma unroll
        for (int dt = 0; dt < 8; ++dt) { const bf16x8 afr = *(const LAS bf16x8*)(tile + (dt * 4 + ks) * 1024 + (j * 4 + (kg ^ ((j >> 2) & 3))) * 16); acc[dt] = MFMA16(afr, bfr[ks], acc[dt]); }
    }
    asm volatile("s_waitcnt vmcnt(0)" ::: "memory");
#pragma unroll
    for (int dt = 0; dt < 8; ++dt) { const int d4 = g * 128 + 16 * dt + 4 * kg; LAS unsigned char* cell = io + j * 256 + (((2 * dt + (kg >> 1)) ^ j) & 15) * 16 + (kg & 1) * 8;
        const f32x4 gv = *(const f32x4*)(p.g_v + layer * 1024 + d4);
        const u32x2 u2 = *(const LAS u32x2*)cell, a2 = *(const LAS u32x2*)(cell + 4096);
        const float g0 = bflo(a2.x), g1 = bfhi(a2.x), g2 = bflo(a2.y), g3 = bfhi(a2.y);
        const float y0 = gelu_t(bflo(u2.x)) * (acc[dt][0] * gv[0] + bias) * (g0 * sigm(g0)), y1 = gelu_t(bfhi(u2.x)) * (acc[dt][1] * gv[1] + bias) * (g1 * sigm(g1));
        const float y2 = gelu_t(bflo(u2.y)) * (acc[dt][2] * gv[2] + bias) * (g2 * sigm(g2)), y3 = gelu_t(bfhi(u2.y)) * (acc[dt][3] * gv[3] + bias) * (g3 * sigm(g3));
        u32x2 w; w.x = pkbf(y0, y1); w.y = pkbf(y2, y3); *(LAS u32x2*)cell = w; }
    { const int rr = lane >> 4, pos = lane & 15;
#pragma unroll
      for (int q = 0; q < 4; ++q) { const int row = 4 * q + rr; const u32x4 v = *(const LAS u32x4*)(io + q * 1024 + lane * 16);
          *(u32x4*)(p.UO + (tok0 + row) * 2048 + g * 128 + 8 * (pos ^ row)) = v; } }
}

constexpr int ATS = 576;
__device__ __forceinline__ void build_bias_table(LAS float* tbl, int h, int tid) {
    const float slope2 = __builtin_amdgcn_exp2f(-0.5f * (float)(h + 1)) * LOG2E;
    for (int i = tid; i < 4 * ATS; i += NWAVES * 64) { const int res = i / ATS, q = i % ATS - 32, dlt = 4 * q + res;
        const int c = (int)(dlt <= 128) + (int)((res == 0) & (dlt <= 512)) + (int)((dlt & 15) == 0);
        const float lg = c == 3 ? 1.5849625007f : (c == 2 ? 1.f : 0.f);
        tbl[i] = (dlt >= 0 && dlt < 2048 && c > 0) ? (lg - slope2 * (float)dlt) : -INFINITY; }
}
struct KVF { bf16x8 kf[2][2]; bf16x8 vf[4]; };
template <int N> __device__ __forceinline__ void attn_wait_v(bf16x8 (&vf)[4]) { (void)vf; }
__device__ __forceinline__ int kswz(int n) { return ((n >> 1) & 1) | (((n >> 3) & 3) << 1); }
__device__ __forceinline__ void attn_dma(const bf16_t* Kbh, const bf16_t* Vbh, int sc, int rp, int lane, LAS unsigned char* stage) {
    const bf16_t* kblk = Kbh + (size_t)((rp * 16 + sc) * 32) * 64;
    const bf16_t* vblk = Vbh + (size_t)((rp * 16 + sc) * 1024) * 32;
#pragma unroll
    for (int q = 0; q < 4; ++q) { const int n = 8 * q + (lane >> 3), pp = lane & 7;
        __builtin_amdgcn_global_load_lds((const unsigned*)(kblk + n * 64 + 8 * (pp ^ kswz(n))), (LAS unsigned*)(stage + q * 1024), 16, 0, 0); }
#pragma unroll
    for (int q = 0; q < 4; ++q) { const int r = 16 * q + (lane >> 2), pp = lane & 3;
        __builtin_amdgcn_global_load_lds((const unsigned*)(vblk + r * 32 + 8 * (pp ^ ((r >> 2) & 3))), (LAS unsigned*)(stage + (4 + q) * 1024), 16, 0, 0); }
}
__device__ __forceinline__ void attn_fetch(bf16x8 (&kf)[2][2], bf16x8 (&vf)[4], const LAS unsigned char* stage, int lane) {
    const int j = lane & 15, kg = lane >> 4;
#pragma unroll
    for (int a = 0; a < 2; ++a) { const int n = 8 * (j >> 2) + 4 * a + (j & 3);
#pragma unroll
        for (int ks = 0; ks < 2; ++ks) kf[a][ks] = *(const LAS bf16x8*)(stage + n * 128 + ((4 * ks + kg) ^ kswz(n)) * 16); }
#pragma unroll
    for (int dt = 0; dt < 4; ++dt) vf[dt] = *(const LAS bf16x8*)(stage + 4096 + (16 * dt + j) * 64 + (kg ^ ((j >> 2) & 3)) * 16);
}
__device__ __forceinline__ float attn_newmax(float mx, float& m, float& l, f32x4 (&o)[4]) {
    { auto r16 = __builtin_amdgcn_permlane16_swap(__float_as_uint(mx), __float_as_uint(mx), false, false); mx = fmaxf(__uint_as_float(r16[0]), __uint_as_float(r16[1]));
      auto r32 = __builtin_amdgcn_permlane32_swap(__float_as_uint(mx), __float_as_uint(mx), false, false); mx = fmaxf(__uint_as_float(r32[0]), __uint_as_float(r32[1])); }
    const float mnew = fmaxf(m, mx);
    if (__any(mnew > m)) { const float alpha = __builtin_amdgcn_exp2f(m - mnew); l *= alpha;
#pragma unroll
        for (int dt = 0; dt < 4; ++dt) o[dt] = o[dt] * alpha; }
    m = mnew; return mnew;
}
template <int NV> __device__ __forceinline__ void attn_compute(const bf16x8 (&kf)[2][2], bf16x8 (&vf)[4], const LAS float* tb0, const bf16x8 (&qf)[2][2], f32x4 (&o)[2][4], float (&m)[2], float (&l)[2]) {
    bf16x8 pf[2];
#pragma unroll
    for (int qt = 0; qt < 2; ++qt) {
        f32x4 s[2];
#pragma unroll
        for (int a = 0; a < 2; ++a) { s[a] = MFMA16(kf[a][0], qf[qt][0], ((f32x4){0.f, 0.f, 0.f, 0.f})); s[a] = MFMA16(kf[a][1], qf[qt][1], s[a]); }
        const LAS float* tb = tb0 + 16 * qt;
        float sv[8]; float mx = -1e30f;
#pragma unroll
        for (int a = 0; a < 2; ++a)
#pragma unroll
            for (int r = 0; r < 4; ++r) { const float x = s[a][r] + tb[7 - 4 * a - r]; sv[4 * a + r] = x; mx = fmaxf(mx, x); }
        const float mnew = attn_newmax(mx, m[qt], l[qt], o[qt]);
        float ps = 0.f;
#pragma unroll
        for (int e = 0; e < 8; ++e) { sv[e] = __builtin_amdgcn_exp2f(sv[e] - mnew); ps += sv[e]; }
        l[qt] += ps;
        u32x4 pw; pw.x = pkbf(sv[0], sv[1]); pw.y = pkbf(sv[2], sv[3]); pw.z = pkbf(sv[4], sv[5]); pw.w = pkbf(sv[6], sv[7]);
        pf[qt] = __builtin_bit_cast(bf16x8, pw);
    }
    attn_wait_v<NV>(vf);
#pragma unroll
    for (int dt = 0; dt < 4; ++dt)
#pragma unroll
        for (int qt = 0; qt < 2; ++qt) o[qt][dt] = MFMA16(vf[dt], pf[qt], o[qt][dt]);
}
template <int NV> __device__ __forceinline__ void attn_compute_far(const bf16x8 (&kf)[2][2], bf16x8 (&vf)[4], const LAS float* tb0, int j, const bf16x8 (&qf)[2][2], f32x4 (&o)[2][4], float (&m)[2], float (&l)[2]) {
    bf16x8 pf[2];
    const int rs_ = j & 3; const bool r1 = (rs_ & 1) != 0, r2 = (rs_ & 2) != 0;
#pragma unroll
    for (int qt = 0; qt < 2; ++qt) {
        float x[2];
#pragma unroll
        for (int a = 0; a < 2; ++a) { f32x4 s = MFMA16(kf[a][0], qf[qt][0], ((f32x4){0.f, 0.f, 0.f, 0.f})); s = MFMA16(kf[a][1], qf[qt][1], s);
            const float lo = r1 ? s[1] : s[0], hi = r1 ? s[3] : s[2]; x[a] = (r2 ? hi : lo) + tb0[16 * qt + 7 - 4 * a - rs_]; }
        const float mnew = attn_newmax(fmaxf(x[0], x[1]), m[qt], l[qt], o[qt]);
        const float p0 = __builtin_amdgcn_exp2f(x[0] - mnew), p1 = __builtin_amdgcn_exp2f(x[1] - mnew);
        l[qt] += p0 + p1;
        const unsigned w0 = pkbf(r1 ? 0.f : p0, r1 ? p0 : 0.f), w1 = pkbf(r1 ? 0.f : p1, r1 ? p1 : 0.f);
        u32x4 pw; pw.x = r2 ? 0u : w0; pw.y = r2 ? w0 : 0u; pw.z = r2 ? 0u : w1; pw.w = r2 ? w1 : 0u;
        pf[qt] = __builtin_bit_cast(bf16x8, pw);
    }
    attn_wait_v<NV>(vf);
#pragma unroll
    for (int dt = 0; dt < 4; ++dt)
#pragma unroll
        for (int qt = 0; qt < 2; ++qt) o[qt][dt] = MFMA16(vf[dt], pf[qt], o[qt][dt]);
}
__device__ __forceinline__ void attn_item(const MixP& p, const LAS float* tbl, int b, int h, int nb, int rho, int lane) {
    const int j = lane & 15, kg = lane >> 4; const size_t rowb = (size_t)b * 2048;
    const bf16_t* Kh = p.K + (size_t)((b * 16 + h) * 4) * 16 * 32 * 64;
    const bf16_t* Vh = p.VT + ((size_t)(b * 4) * 16 * 1024 + h * 64) * 32;
    f32x4 o[2][4]; float m[2] = {-1e30f, -1e30f}, l[2] = {0.f, 0.f};
#pragma unroll
    for (int qt = 0; qt < 2; ++qt)
#pragma unroll
        for (int dt = 0; dt < 4; ++dt) o[qt][dt] = (f32x4){0.f, 0.f, 0.f, 0.f};
    const int lb = 4 * j - 32 * kg, sc0 = nb > 0 ? nb - 1 : 0, nnear = 3 * (nb - sc0 + 1), nst = nb + 1 + nnear;
#define ATT_DECODE(t, sc_, rp_) do { if ((t) == 0) { sc_ = nb; rp_ = rho; } else if ((t) <= nnear) { const int e_ = (t) - 1; sc_ = nb - e_ / 3; rp_ = (rho + 1 + e_ % 3) & 3; } else { sc_ = nb - ((t) - nnear); rp_ = rho; } } while (0)
    LAS unsigned char* ring = (LAS unsigned char*)tbl - (RING_BYTES + 1024) + __builtin_amdgcn_readfirstlane((int)(threadIdx.x >> 6)) * 16384;
    const int R8 = lane >> 3, pos8 = lane & 7;
#define ATT_ROWTOK(R) (rowb + 128 * nb + 64 * ((R) >> 4) + rho + 4 * ((R) & 15))
#pragma unroll
    for (int q = 0; q < 4; ++q) { const int R = 8 * q + R8;
        __builtin_amdgcn_global_load_lds((const unsigned*)(p.Q + ATT_ROWTOK(R) * DM + h * 64 + 8 * (pos8 ^ ((R >> 1) & 7))), (LAS unsigned*)(ring + 8192 + q * 1024), 16, 0, 0); }
    { int sc_, rp_; ATT_DECODE(0, sc_, rp_); attn_dma(Kh, Vh, sc_, rp_, lane, ring); }
    asm volatile("s_waitcnt vmcnt(8)" ::: "memory");
    bf16x8 qf[2][2];
#pragma unroll
    for (int qt = 0; qt < 2; ++qt) { const int R = 16 * qt + j;
#pragma unroll
        for (int ks = 0; ks < 2; ++ks) qf[qt][ks] = *(const LAS bf16x8*)(ring + 8192 + R * 128 + ((4 * ks + kg) ^ ((R >> 1) & 7)) * 16); }
    asm volatile("s_waitcnt lgkmcnt(0)" : "+v"(qf[0][0]), "+v"(qf[0][1]), "+v"(qf[1][0]), "+v"(qf[1][1]) : : "memory");
    if (nst > 1) { int sc_, rp_; ATT_DECODE(1, sc_, rp_); attn_dma(Kh, Vh, sc_, rp_, lane, ring + 8192); }
    for (int t = 0; t < nst; ++t) {
        LAS unsigned char* stage = ring + (t & 1) * 8192;
        if (t + 1 < nst) asm volatile("s_waitcnt vmcnt(8)" ::: "memory"); else asm volatile("s_waitcnt vmcnt(0)" ::: "memory");
        bf16x8 kf[2][2], vf[4];
        attn_fetch(kf, vf, stage, lane);
        asm volatile("s_waitcnt lgkmcnt(0)" : "+v"(kf[0][0]), "+v"(kf[0][1]), "+v"(kf[1][0]), "+v"(kf[1][1]), "+v"(vf[0]), "+v"(vf[1]), "+v"(vf[2]), "+v"(vf[3]) : : "memory");
        if (t + 2 < nst) { int sc_, rp_; ATT_DECODE(t + 2, sc_, rp_); attn_dma(Kh, Vh, sc_, rp_, lane, stage); }
        if (t + 1 == nst) {
#pragma unroll
            for (int q = 0; q < 4; ++q) { const int R = 8 * q + R8;
                __builtin_amdgcn_global_load_lds((const unsigned*)(p.BG + ATT_ROWTOK(R) * DM + h * 64 + 8 * (pos8 ^ ((R >> 1) & 7))), (LAS unsigned*)(ring + ((t + 1) & 1) * 8192 + q * 1024), 16, 0, 0); } }
        int sc_, rp_; ATT_DECODE(t, sc_, rp_);
        const int d0 = 128 * (nb - sc_) + (rho - rp_) + lb; const LAS float* tb0 = tbl + ((d0 & 3) * ATS + (d0 >> 2) + 32 - 7);
        if (nb - sc_ >= 5) attn_compute_far<0>(kf, vf, tb0, j, qf, o, m, l); else attn_compute<0>(kf, vf, tb0, qf, o, m, l);
    }
#undef ATT_DECODE
    asm volatile("s_waitcnt vmcnt(0)" ::: "memory");
    LAS unsigned char* bgst = ring + (nst & 1) * 8192; LAS unsigned char* outst = ring + ((nst + 1) & 1) * 8192;
#pragma unroll
    for (int qt = 0; qt < 2; ++qt) { float lt = l[qt]; lt += __shfl_xor(lt, 16); lt += __shfl_xor(lt, 32); const float inv = 1.0f / lt;
        const int R = 16 * qt + j;
#pragma unroll
        for (int dt = 0; dt < 4; ++dt) { const int cell = R * 128 + (((2 * dt + (kg >> 1)) ^ ((R >> 1) & 7)) * 16) + (kg & 1) * 8;
            const u32x2 g2 = *(const LAS u32x2*)(bgst + cell);
            const float b0 = bflo(g2.x), b1 = bfhi(g2.x), b2 = bflo(g2.y), b3 = bfhi(g2.y);
            u32x2 w; w.x = pkbf(o[qt][dt][0] * inv * (b0 * sigm(b0)), o[qt][dt][1] * inv * (b1 * sigm(b1))); w.y = pkbf(o[qt][dt][2] * inv * (b2 * sigm(b2)), o[qt][dt][3] * inv * (b3 * sigm(b3)));
            *(LAS u32x2*)(outst + cell) = w; } }
#pragma unroll
    for (int q = 0; q < 4; ++q) { const int R = 8 * q + R8; const u32x4 v = *(const LAS u32x4*)(outst + q * 1024 + lane * 16);
        *(u32x4*)(p.QO + ATT_ROWTOK(R) * 2048 + h * 64 + 8 * (pos8 ^ ((R >> 1) & 7))) = v; }
    asm volatile("s_waitcnt lgkmcnt(0)" ::: "memory");
#undef ATT_ROWTOK
}

__device__ __forceinline__ float wave_sum(float v) {
#pragma unroll
    for (int o = 1; o < 64; o <<= 1) v += __shfl_xor(v, o);
    return v;
}
__device__ __forceinline__ void tr_tile(const float* W, int N, int k0, int n0, const float* gk, bf16_t* dst, int K, LAS float* scr, int lane) {
#pragma unroll 8
    for (int i = 0; i < 32; ++i) { const int kk = 2 * i + (lane >> 5); float v = W[(size_t)(k0 + kk) * N + n0 + (lane & 31)]; if (gk) v *= gk[k0 + kk]; scr[kk * 33 + (lane & 31)] = v; }
    asm volatile("s_waitcnt lgkmcnt(0)" ::: "memory");
    const int c = lane & 7;
#pragma unroll
    for (int jj = 0; jj < 4; ++jj) { const int n = (lane >> 3) + 8 * jj; const LAS float* s = scr + (8 * c) * 33 + n;
        u32x4 o; o.x = pkbf(s[0 * 33], s[1 * 33]); o.y = pkbf(s[2 * 33], s[3 * 33]); o.z = pkbf(s[4 * 33], s[5 * 33]); o.w = pkbf(s[6 * 33], s[7 * 33]);
        *(u32x4*)(dst + (size_t)n * K + k0 + 8 * c) = o; }
    asm volatile("s_waitcnt lgkmcnt(0)" ::: "memory");
}

#define XB_TMO      128
#define XB_XCNT(j)  (256  + 64 * (j))
#define XB_XSUB(j)  (1280 + 64 * (j))
#define XB_XGEN(j)  (2304 + 64 * (j))
#define XB_TOP      3328
#define XB_TOPGEN   3392
#define XCD_BAR_WORDS 3456
#define XB_SPIN_CAP (1u << 18)

__device__ __forceinline__ unsigned xb_ld(unsigned* p)              { return __hip_atomic_load(p, __ATOMIC_RELAXED, __HIP_MEMORY_SCOPE_AGENT); }
__device__ __forceinline__ unsigned xb_add(unsigned* p, unsigned v) { return __hip_atomic_fetch_add(p, v, __ATOMIC_RELAXED, __HIP_MEMORY_SCOPE_AGENT); }
__device__ __forceinline__ unsigned xb_xcc_id() { return (unsigned)__builtin_amdgcn_s_getreg((3 << 11) | 20) & 0xFu; }
#define XB_SPIN(cond, bar) do { unsigned _sp = 0; while (cond) { __builtin_amdgcn_s_sleep(1); \
    if ((++_sp & 255u) == 0u) { if (xb_ld(&(bar)[XB_TMO])) break; if (_sp > XB_SPIN_CAP) { atomicAdd(&(bar)[XB_TMO], 1u); break; } } } } while (0)

struct XcdBarrier {
    unsigned* bar; unsigned x;
    volatile LAS unsigned* st;
};

__device__ __forceinline__ XcdBarrier xcd_barrier_post(unsigned* bar, volatile LAS unsigned* st) {
    XcdBarrier b; b.bar = bar; b.x = xb_xcc_id(); b.st = st;
    if (threadIdx.x == 0) st[2] = xb_add(&bar[XB_XCNT(b.x)], 1u);
    return b;
}
__device__ __forceinline__ void xcd_barrier_complete(unsigned* bar, unsigned x, unsigned& nloc, unsigned& nx) {
    const unsigned G = gridDim.x * gridDim.y * gridDim.z;
    unsigned sum, cnt, mine, sp = 0u;
    for (;;) {
        sum = 0u; cnt = 0u; mine = 0u;
#pragma unroll
        for (unsigned j = 0; j < 16; ++j) { const unsigned c = xb_ld(&bar[XB_XCNT(j)]); sum += c; cnt += (c > 0u) ? 1u : 0u; mine = (j == x) ? c : mine; }
        if (sum == G) break;
        __builtin_amdgcn_s_sleep(1);
        if ((++sp & 255u) == 0u) { if (xb_ld(&bar[XB_TMO])) break; if (sp > XB_SPIN_CAP) { atomicAdd(&bar[XB_TMO], 1u); break; } }
    }
    nloc = mine > 0u ? mine : 1u; nx = cnt > 0u ? cnt : 1u;
}

__device__ __forceinline__ void xcd_barrier(const XcdBarrier& b) {
    asm volatile("s_waitcnt vmcnt(0)" ::: "memory");
    __syncthreads();
    if (threadIdx.x == 0) {
        unsigned* bar = b.bar;
        __builtin_amdgcn_s_waitcnt(0);
        unsigned nloc = b.st[0], nx = b.st[1];
        if (nloc == 0u) { xcd_barrier_complete(bar, b.x, nloc, nx); b.st[0] = nloc; b.st[1] = nx; }
        const unsigned old = xb_add(&bar[XB_XSUB(b.x)], 1u);
        const unsigned gen = old / nloc;
        if (old + 1u == (gen + 1u) * nloc) {
            __builtin_amdgcn_fence(__ATOMIC_RELEASE, "agent");
            asm volatile("s_waitcnt vmcnt(0)" ::: "memory");
            const unsigned og = xb_add(&bar[XB_TOP], 1u);
            const unsigned tg = og / nx;
            if (og + 1u == (tg + 1u) * nx) xb_add(&bar[XB_TOPGEN], 1u);
            else XB_SPIN(xb_ld(&bar[XB_TOPGEN]) == tg, bar);
            __builtin_amdgcn_fence(__ATOMIC_ACQUIRE, "agent");
            xb_add(&bar[XB_XGEN(b.x)], 1u);
            asm volatile("s_waitcnt vmcnt(0)" ::: "memory");
        } else {
            XB_SPIN(xb_ld(&bar[XB_XGEN(b.x)]) == gen, bar);
            __builtin_amdgcn_fence(__ATOMIC_ACQUIRE, "agent");
            asm volatile("s_waitcnt vmcnt(0)" ::: "memory");
        }
    }
    __syncthreads();
}

__device__ __forceinline__ int lane_id() { int t = threadIdx.x; asm volatile("" : "+v"(t)); return t & 63; }
struct TrDesc { const float* W; const float* gk; bf16_t* dst; int N, k0, n0, K; };
struct TrRegs { f32x4 v[8]; float g[8]; };
__device__ __forceinline__ void tr_load(TrRegs& r, const TrDesc& d, int lane) {
#pragma unroll
    for (int i = 0; i < 8; ++i) { const int kk = 8 * i + (lane >> 3); r.v[i] = *(const f32x4*)(d.W + (size_t)(d.k0 + kk) * d.N + d.n0 + 4 * (lane & 7)); r.g[i] = d.gk ? d.gk[d.k0 + kk] : 1.f; }
}
__device__ __forceinline__ void tr_store(const TrRegs& r, const TrDesc& d, LAS float* scr, int lane) {
#pragma unroll
    for (int i = 0; i < 8; ++i) { const int kk = 8 * i + (lane >> 3); LAS float* sp = scr + kk * 33 + 4 * (lane & 7);
        sp[0] = r.v[i][0] * r.g[i]; sp[1] = r.v[i][1] * r.g[i]; sp[2] = r.v[i][2] * r.g[i]; sp[3] = r.v[i][3] * r.g[i]; }
    asm volatile("s_waitcnt lgkmcnt(0)" ::: "memory");
    const int c = lane & 7;
#pragma unroll
    for (int jj = 0; jj < 4; ++jj) { const int n = (lane >> 3) + 8 * jj; const LAS float* s = scr + (8 * c) * 33 + n;
        u32x4 o; o.x = pkbf(s[0 * 33], s[1 * 33]); o.y = pkbf(s[2 * 33], s[3 * 33]); o.z = pkbf(s[4 * 33], s[5 * 33]); o.w = pkbf(s[6 * 33], s[7 * 33]);
        *(u32x4*)(d.dst + (size_t)n * d.K + d.k0 + 8 * c) = o; }
    asm volatile("s_waitcnt lgkmcnt(0)" ::: "memory");
}
__device__ __forceinline__ TrDesc tr_desc(int it, const float* w_in, const float* g_norm, const float* w_pa, const float* w_pb, const float* w_out, bf16_t* WTM, bf16_t* WTS, bf16_t* WTA, bf16_t* WTO) {
    constexpr int T_IN = 16 * 288, T_SQ = 16 * 32;
    TrDesc d;
    if (it < DEPTH * T_IN) {
        const int l = it / T_IN, r = it % T_IN, kb = r / 288, nbk = r % 288, n0 = 32 * nbk;
        bf16_t* dst;
        if (n0 < 1024) dst = WTM + ((size_t)l * N_MAIN + n0) * DM;
        else if (n0 < 2048) dst = WTS + ((size_t)l * N_SW + (n0 - 1024)) * DM;
        else if (n0 < 5120) dst = WTM + ((size_t)l * N_MAIN + (n0 - 1024)) * DM;
        else if (n0 < 6144) dst = WTS + ((size_t)l * N_SW + 1024 + (n0 - 5120)) * DM;
        else dst = WTM + ((size_t)l * N_MAIN + (n0 - 2048)) * DM;
        d.W = w_in + (size_t)l * DM * IN_COLS; d.gk = g_norm + l * DM; d.dst = dst; d.N = IN_COLS; d.k0 = 64 * kb; d.n0 = n0; d.K = DM;
    } else {
        const int r0 = it - DEPTH * T_IN, which = r0 / (DEPTH * T_SQ), r1 = r0 % (DEPTH * T_SQ), l = r1 / T_SQ, r = r1 % T_SQ, kb = r / 32, nbk = r % 32;
        d.W = (which == 0 ? w_pa : which == 1 ? w_pb : w_out) + (size_t)l * DM * DM; d.gk = nullptr; d.N = DM; d.k0 = 64 * kb; d.n0 = 32 * nbk;
        if (which == 2) { d.dst = WTO + ((size_t)l * DM + 32 * nbk) * DM; d.K = DM; }
        else { d.dst = WTA + ((size_t)l * DM + 32 * nbk) * 2048 + which * 1024; d.K = 2048; }
    }
    return d;
}
struct Args { const float* in[10]; float* out; unsigned char* ws; int ph_lo, ph_hi; };
constexpr int N_PHASES = 2 + 4 * DEPTH;

__global__ void __launch_bounds__(NWAVES * 64, 2) hyb_fwd(Args args) {
    extern __shared__ __attribute__((aligned(16))) unsigned char lds[];
    LAS unsigned char* L = (LAS unsigned char*)lds;
    const int tid = threadIdx.x, wave = __builtin_amdgcn_readfirstlane(tid >> 6);
#define lane lane_id()
    const int G = gridDim.x, bx = blockIdx.x, vcu = (G % 8 == 0) ? (bx % 8) * (G / 8) + bx / 8 : bx;
    const int gw = vcu * NWAVES + wave, NGW = G * NWAVES;
    const float* x_in = args.in[0]; const float* g_norm = args.in[1]; const float* w_in = args.in[2]; const float* w_s = args.in[3]; const float* b_s = args.in[4];
    const float* g_v = args.in[5]; const float* w_pa = args.in[6]; const float* w_pb = args.in[7]; const float* w_out = args.in[8]; const float* g_final = args.in[9];
#define WS_PTRS() unsigned char* ws = args.ws; asm volatile("" : "+s"(ws)); \
    float* xsq = (float*)(ws + WS_XSQ); float* vsq = (float*)(ws + WS_VSQ); \
    bf16_t* WM = (bf16_t*)(ws + WS_WM); bf16_t* WTM = (bf16_t*)(ws + WS_WT_MAIN); bf16_t* WTS = (bf16_t*)(ws + WS_WT_SW); \
    bf16_t* WTA = (bf16_t*)(ws + WS_WT_A); bf16_t* WTB = (bf16_t*)(ws + WS_WT_B); bf16_t* WTO = (bf16_t*)(ws + WS_WT_O); \
    bf16_t* XB = (bf16_t*)(ws + WS_XB); bf16_t* XBP = (bf16_t*)(ws + WS_XBP); bf16_t* ACT = (bf16_t*)(ws + WS_ACT); \
    bf16_t* GVT = (bf16_t*)(ws + WS_GVT); bf16_t* VT = (bf16_t*)(ws + WS_VT); float* T = (float*)(ws + WS_T); bf16_t* MG = (bf16_t*)(ws + WS_MG); \
    bf16_t* bU = ACT; bf16_t* bAG = ACT + ACT_STRIDE; bf16_t* bQ = ACT + 2 * ACT_STRIDE; bf16_t* bK = ACT + 3 * ACT_STRIDE; bf16_t* bBG = ACT + 4 * ACT_STRIDE; \
    bf16_t* bGA = ACT + 5 * ACT_STRIDE; bf16_t* bGB = ACT + 6 * ACT_STRIDE; \
    (void)xsq; (void)vsq; (void)WM; (void)WTM; (void)WTS; (void)WTA; (void)WTB; (void)WTO; (void)XB; (void)XBP; (void)GVT; (void)VT; (void)T; (void)MG; \
    (void)bU; (void)bAG; (void)bQ; (void)bK; (void)bBG; (void)bGA; (void)bGB
    const int lo = args.ph_lo, hi = args.ph_hi;
#define IN(k) (lo <= (k) && (k) < hi)
#define SEAM(k) do { if (IN(k) && IN((k) + 1)) { xcd_barrier(xbar); } } while (0)

    if (IN(0)) {
        WS_PTRS();
        const int lane0 = lane_id();
        LAS float* scr = (LAS float*)(L + wave * 16384);
        constexpr int T_IN = 16 * 288, T_SQ = 16 * 32, NT = DEPTH * (T_IN + 3 * T_SQ);
#define tile_desc(it) tr_desc((it), w_in, g_norm, w_pa, w_pb, w_out, WTM, WTS, WTA, WTO)
        { TrRegs ra, rb;
          if (gw < NT) tr_load(ra, tile_desc(gw), lane0);
          for (int it = gw; it < NT; it += 2 * NGW) {
              const int it1 = it + NGW, it2 = it + 2 * NGW;
              if (it1 < NT) tr_load(rb, tile_desc(it1), lane0);
              tr_store(ra, tile_desc(it), scr, lane0);
              if (it2 < NT) tr_load(ra, tile_desc(it2), lane0);
              if (it1 < NT) tr_store(rb, tile_desc(it1), scr, lane0);
          } }
#undef tile_desc
        for (int m0 = gw; m0 < M_TOK; m0 += 4 * NGW) {
            f32x4 v[4][4];
#pragma unroll
            for (int rr = 0; rr < 4; ++rr) { const int mrow = m0 + rr * NGW; if (mrow < M_TOK) { const f32x4* xr = (const f32x4*)(x_in + (size_t)mrow * DM) + lane0;
#pragma unroll
                for (int q = 0; q < 4; ++q) v[rr][q] = xr[64 * q]; } }
#pragma unroll
            for (int rr = 0; rr < 4; ++rr) { const int mrow = m0 + rr * NGW; if (mrow < M_TOK) { float s = 0.f;
#pragma unroll
                for (int q = 0; q < 4; ++q) s += (v[rr][q][0] * v[rr][q][0] + v[rr][q][1] * v[rr][q][1]) + (v[rr][q][2] * v[rr][q][2] + v[rr][q][3] * v[rr][q][3]);
                s = wave_sum(s);
                u32x2* o1 = (u32x2*)(XB + (size_t)mrow * DM) + lane0;
#pragma unroll
                for (int q = 0; q < 4; ++q) { u32x2 w; w.x = pkbf(v[rr][q][0], v[rr][q][1]); w.y = pkbf(v[rr][q][2], v[rr][q][3]); o1[64 * q] = w; }
                if (lane0 == 0) xsq[mrow] = s; } }
        }
        const int gt = vcu * (NWAVES * 64) + tid, NGT = G * NWAVES * 64;
        for (int i = gt; i < 4 * M_TOK; i += NGT) { xsq[M_TOK + i] = 0.f; vsq[i] = 0.f; }
        for (int i = gt; i < XCD_BAR_WORDS; i += NGT) ((unsigned*)(ws + WS_BAR))[i] = 0u;
        for (int i = gt; i < DEPTH * 8 * 128 * 128; i += NGT) { const int sg = i & 127, t = (i >> 7) & 127, s = (sg & 31) * 4 + (sg >> 5);
            const float v = (s <= t) ? w_s[(size_t)(i >> 14) * 16384 + t * 128 + s] : 0.f; WM[i] = (bf16_t)(pkbf(v, 0.f) & 0xffffu); }
    }
    XcdBarrier xbar; xbar.bar = (unsigned*)(args.ws + WS_BAR); xbar.x = 0; xbar.st = (volatile LAS unsigned*)(L + RING_BYTES + 64);
    if (tid < 2) xbar.st[tid] = 0u;
    if (IN(0) && IN(1)) { __threadfence(); cg::this_grid().sync(); }
    if (hi - lo > 1) xbar = xcd_barrier_post((unsigned*)(args.ws + WS_BAR), (volatile LAS unsigned*)(L + RING_BYTES + 64));

    for (int layer = 0; layer < DEPTH; ++layer) {
        const int ph = 1 + 4 * layer;
        if (IN(ph)) {
            WS_PTRS();
            { pg8::Gemm g{XB, WTM + (size_t)layer * N_MAIN * DM, M_TOK, N_MAIN, DM}; pg8::StaticOrder S; S.init(M_TOK, N_MAIN, G, bx);
              EpiMain E{ACT, xsq + layer * M_TOK, MG};
              pg8::gemm_phase<EpiMain, pg8::StaticOrder, true, true>(L, g, S, E);
              if (DUP & 1) pg8::gemm_phase<EpiMain, pg8::StaticOrder, true, true>(L, g, S, E); }
            { pg8::Gemm g{WTS + (size_t)layer * N_SW * DM, XB, N_SW, M_TOK, DM, 1};     pg8::StaticOrder S; S.init(N_SW, M_TOK, G, bx);
              EpiSw E{GVT, VT, xsq + layer * M_TOK, vsq + layer * M_TOK};
              pg8::gemm_phase<EpiSw, pg8::StaticOrder, true, true>(L, g, S, E); }
        }
        SEAM(ph);
        if (IN(ph + 1)) {
            WS_PTRS(); int ln = lane; asm volatile("" : "+v"(ln));
            MixP p{WM, GVT, VT, (const bf16_t*)MG, bU, bQ, bAG, bBG, vsq + layer * M_TOK, b_s, g_v, (bf16_t*)T, (bf16_t*)T + 1024};
            { int k = 0;
              if (vcu < 1024) gating_stage(p, vcu, L, wave, ln);
              for (int itw = vcu; itw < 1024; itw += G, ++k) {
                  asm volatile("s_waitcnt vmcnt(0)" ::: "memory"); __syncthreads();
                  if (itw + G < 1024) gating_stage(p, itw + G, L + ((k + 1) & 1) * 32768, wave, ln);
                  gating_item(p, layer, itw * 8 + wave, ln, L + (k & 1) * 32768, L + 65536 + wave * 8192);
              }
              __syncthreads(); }
            LAS float* tbl = (LAS float*)(L + RING_BYTES + 1024);
            int vid = vcu;
            if (hi - lo > 1) {
                if (threadIdx.x == 0) { unsigned pre = 0u;
                    for (unsigned jx = 0; jx < 16; ++jx) { const unsigned cx = xb_ld(&xbar.bar[XB_XCNT(jx)]); if (jx < xbar.x) pre += cx; }
                    xbar.st[3] = pre + xbar.st[2]; }
                __syncthreads(); vid = (int)xbar.st[3]; }
            for (int v = vid; v < 256; v += G) {
                const int h = v >> 4, q = (v & 15) * 8 + wave, rho = q & 3, nbsel = (q >> 2) & 15;
                __syncthreads(); build_bias_table(tbl, h, tid); __syncthreads();
                for (int r = 0; r < 4; ++r) {
                    if (DUP & 8) { MixP pd = p; pd.QO = MG; attn_item(pd, tbl, 2 * r + (q >> 6), h, (r & 1) ? 15 - nbsel : nbsel, rho, ln); }
                    attn_item(p, tbl, 2 * r + (q >> 6), h, (r & 1) ? 15 - nbsel : nbsel, rho, ln); }
            }
            __syncthreads();
        }
        SEAM(ph + 1);
        if (IN(ph + 2)) {
            WS_PTRS();
            pg8::Gemm g{(const bf16_t*)T, WTA + (size_t)layer * DM * 2048, M_TOK, DM, 2048}; pg8::StaticOrder S; S.init(M_TOK, DM, G, bx);
            EpiMerge2 E{bGA, bGB, MG}; pg8::gemm_phase<EpiMerge2, pg8::StaticOrder, true, true>(L, g, S, E);
        }
        SEAM(ph + 2);
        if (IN(ph + 3)) {
            WS_PTRS();
            pg8::Gemm g{MG, WTO + (size_t)layer * DM * DM, M_TOK, DM, DM}; pg8::StaticOrder S; S.init(M_TOK, DM, G, bx);
            EpiOut E{layer == 0 ? x_in : args.out, args.out, XB, XBP, xsq + (layer + 1) * M_TOK};
            pg8::gemm_phase<EpiOut, pg8::StaticOrder, true, true>(L, g, S, E);
        }
        SEAM(ph + 3);
    }
    if (IN(N_PHASES - 1)) {
        WS_PTRS();
        const float* fs = xsq + DEPTH * M_TOK; const int lane1 = lane_id();
        for (int mrow = gw; mrow < M_TOK; mrow += NGW) { const float rs = rs_of(fs[mrow]); f32x4* xr = (f32x4*)(args.out + (size_t)mrow * DM) + lane1;
#pragma unroll
            for (int q = 0; q < 4; ++q) { const f32x4 gq = *((const f32x4*)g_final + lane1 + 64 * q); xr[64 * q] = xr[64 * q] * rs * gq; } }
    }
#undef IN
#undef SEAM
#undef WS_PTRS
#undef lane
}


extern "C" void kernel_launch(void* const* d_in, const int* in_sizes, int n_in, void* d_out, int out_size, void* d_ws, size_t ws_size, hipStream_t stream) {
    static int grid = 0;
    if (grid == 0) {
        if (n_in != 10 || in_sizes[0] != M_TOK * DM || out_size != M_TOK * DM || ws_size < WS_END) { fprintf(stderr, "kernel_launch: unexpected shapes / workspace (%d inputs, ws %zu, need %zu)\n", n_in, ws_size, (size_t)WS_END); grid = -1; return; }
        int dev = 0, cus = 0, per_cu = 0;
        (void)hipGetDevice(&dev); (void)hipDeviceGetAttribute(&cus, hipDeviceAttributeMultiprocessorCount, dev);
        if (hipFuncSetAttribute((const void*)hyb_fwd, hipFuncAttributeMaxDynamicSharedMemorySize, LDS_BYTES) != hipSuccess) { fprintf(stderr, "kernel_launch: hipFuncSetAttribute failed\n"); grid = -1; return; }
        if (hipOccupancyMaxActiveBlocksPerMultiprocessor(&per_cu, (const void*)hyb_fwd, NWAVES * 64, LDS_BYTES) != hipSuccess || per_cu != 1) per_cu = 1;
        (void)hipGetLastError();
        if (cus <= 0) cus = 256;
        grid = cus * per_cu;
    }
    if (grid < 0) return;
    Args a{};
    for (int i = 0; i < 10; ++i) a.in[i] = (const float*)d_in[i];
    a.out = (float*)d_out; a.ws = (unsigned char*)d_ws;
#if MK_MULTI
    for (int ph = 0; ph < N_PHASES; ++ph) { a.ph_lo = ph; a.ph_hi = ph + 1; hipLaunchKernelGGL(hyb_fwd, dim3(grid), dim3(NWAVES * 64), LDS_BYTES, stream, a); }
#else
    a.ph_lo = 0; a.ph_hi = N_PHASES;
    void* kargs[] = {&a};
    hipError_t e = hipLaunchCooperativeKernel((const void*)hyb_fwd, dim3(grid), dim3(NWAVES * 64), kargs, LDS_BYTES, stream);
    if (e != hipSuccess) fprintf(stderr, "kernel_launch: cooperative launch failed: %s (grid %d)\n", hipGetErrorString(e), grid);
#endif
}
```

```cpp
#include <hip/hip_runtime.h>
#include <hip/hip_cooperative_groups.h>
#include <cstdio>
#include <cstdint>
namespace cg = cooperative_groups;
#ifndef DUP
#define DUP 0
#endif
#ifndef MK_MULTI
#define MK_MULTI 0
#endif
namespace pg8 {
#define PG8_LAS __attribute__((address_space(3)))
typedef unsigned short bf16_t;
typedef short bf16x8 __attribute__((ext_vector_type(8)));
typedef float f32x4 __attribute__((ext_vector_type(4)));
typedef unsigned u32x4 __attribute__((ext_vector_type(4)));
constexpr int BM = 256, BK = 64, HALF = 128, HTB = HALF * BK * 2  , STAGE_BYTES = 8 * HTB, NXCD = 8, WGM = 8;

__host__ __device__ __forceinline__ int lds_byte(int r, int c) { const int st = (r >> 4) * 2 + (c >> 5), rr = r & 15, cc = c & 31, ob = rr * 64 + cc * 2; return st * 1024 + (ob ^ (((ob >> 9) & 1) << 5)); }
__host__ __device__ __forceinline__ void stage_rc(int b, int& R, int& C) { const int st = b / 1024, sb = b % 1024, swz = sb ^ (((sb >> 9) & 1) << 5); R = (st >> 1) * 16 + swz / 64; C = (st & 1) * 32 + (swz % 64) / 2; }
__host__ __device__ __forceinline__ int perm32(int rho) { const int n = rho >> 4, i = rho & 15; return 8 * (i >> 2) + 4 * n + (i & 3); }

struct Unit { int pm, pn; };
struct Gemm { const bf16_t* A; const bf16_t* Bt; int M, N, K; int bpi; };

struct StaticOrder {
    int nM, nN, nwg, G, c;
    __host__ __device__ void init(int M, int N, int G_, int c_) { nM = M / BM; nN = N / BM; nwg = nM * nN; G = G_; c = c_; }
    __host__ __device__ bool next(int i, Unit& u) const {
        const long L = (long)i * G + c; if (L >= nwg) return false;
        int wgid = (int)L; { const int q = nwg / NXCD, r = nwg % NXCD, xcd = wgid % NXCD, off = wgid / NXCD; wgid = (xcd < r ? xcd * (q + 1) : r * (q + 1) + (xcd - r) * q) + off; }
        const int nig = WGM * nN, gid = wgid / nig, fm = gid * WGM, gsz = (nM - fm) < WGM ? (nM - fm) : WGM;
        u.pm = fm + ((wgid % nig) % gsz); u.pn = (wgid % nig) / gsz; return true;
    }
    __device__ __forceinline__ void a_ready(const Unit&) const {}
    __device__ __forceinline__ void done(const Unit&) const {}
};
__device__ __forceinline__ unsigned cvt_pk_bf16(float lo, float hi) { unsigned r; asm volatile("v_cvt_pk_bf16_f32 %0, %1, %2" : "=v"(r) : "v"(lo), "v"(hi)); return r; }
template <class Epi, class Sched, bool ALIGN_EPI = false, bool SP2 = false>
__device__ __forceinline__ void gemm_phase(PG8_LAS unsigned char* lds, const Gemm g, const Sched& S, const Epi& E) {
    int tid = threadIdx.x; asm volatile("" : "+v"(tid));
    const int wid = __builtin_amdgcn_readfirstlane(tid >> 6), lane = tid & 63, wr = wid >> 2, wc = wid & 3, fr = lane & 15, fq = lane >> 4;
    const int K = g.K, nt = K / BK;
    const int brs = g.bpi ? 4 : 1;
    unsigned voffA[2], voffB[2];
#pragma unroll
    for (int i = 0; i < 2; ++i) { int R, C; stage_rc(tid * 16 + i * 8192, R, C); const int Rb = Epi::PERM ? ((R & ~31) + perm32(R & 31)) : R;
        voffA[i] = (unsigned)(R * K + C) * 2u; voffB[i] = (unsigned)(Rb * brs * K + C) * 2u; }
    const size_t kstep = (size_t)(BK * 2);
    const size_t hstep = (size_t)HALF * K * 2;
    const size_t tstep = 2 * hstep;
    const size_t hstepB = hstep * brs;
#define PG8_BBASE(pn) ((const char*)g.Bt + (g.bpi ? (size_t)((((pn) * 256) & ~2047) | ((((pn) * 256) & 511) << 2) | ((((pn) * 256) >> 9) & 3)) * (size_t)(K * 2) : (size_t)(pn) * tstep))
    const unsigned ldsw = (unsigned)wid * 1024u;
    const int aoff = lds_byte(wr * 64 + fr, fq * 8), boff = lds_byte(wc * 32 + fr, fq * 8);
#define PG8_SA(b, h) (((b) * 2 + (h)) * HTB)
#define PG8_SB(b, h) ((4 + (b) * 2 + (h)) * HTB)
#define PG8_STAGE(bufoff, gbase, voff) do { _Pragma("unroll") for (int _i = 0; _i < 2; ++_i) \
        __builtin_amdgcn_global_load_lds((const unsigned*)((const char*)(gbase) + (voff)[_i]), (PG8_LAS unsigned*)(lds + (bufoff) + ldsw + _i * 8192), 16, 0, 0); } while (0)
#define PG8_LDA(dst, b, h) do { _Pragma("unroll") for (int m = 0; m < 4; ++m) _Pragma("unroll") for (int k = 0; k < 2; ++k) dst[m][k] = *(const PG8_LAS bf16x8*)(lds + PG8_SA(b, h) + aoff + m * 2048 + k * 1024); } while (0)
#define PG8_LDB(dst, b, h) do { _Pragma("unroll") for (int n = 0; n < 2; ++n) _Pragma("unroll") for (int k = 0; k < 2; ++k) dst[n][k] = *(const PG8_LAS bf16x8*)(lds + PG8_SB(b, h) + boff + n * 2048 + k * 1024); } while (0)
#define PG8_MMA(ai, bj, At, Bt) do { __builtin_amdgcn_s_setprio(1); _Pragma("unroll") for (int m = 0; m < 4; ++m) _Pragma("unroll") for (int n = 0; n < 2; ++n) _Pragma("unroll") for (int k = 0; k < 2; ++k) \
        acc[ai][bj][m][n] = __builtin_amdgcn_mfma_f32_16x16x32_bf16(Bt[n][k], At[m][k], acc[ai][bj][m][n], 0, 0, 0); __builtin_amdgcn_s_setprio(0); } while (0)
#define PG8_WAIT_V(n) asm volatile("s_waitcnt vmcnt(" #n ")" ::: "memory")
#define PG8_WAIT_L(n) asm volatile("s_waitcnt lgkmcnt(" #n ")" ::: "memory")
#define PG8_BAR __builtin_amdgcn_s_barrier()
#define PG8_SCHED __builtin_amdgcn_sched_barrier(0)
    Unit cur, nxt; int ui = 0;
    if (!S.next(0, cur)) return;
    f32x4 acc[2][2][4][2];
#pragma unroll
    for (int a = 0; a < 2; ++a)
#pragma unroll
        for (int b = 0; b < 2; ++b)
#pragma unroll
            for (int m = 0; m < 4; ++m)
#pragma unroll
                for (int n = 0; n < 2; ++n) acc[a][b][m][n] = (f32x4){0.f, 0.f, 0.f, 0.f};
    bf16x8 At[4][2], B0[2][2], B1[2][2];
    const char* cA = (const char*)g.A + (size_t)cur.pm * tstep; const char* cB = PG8_BBASE(cur.pn);
    S.a_ready(cur);
    if constexpr (SP2) {
        PG8_STAGE(PG8_SB(0, 0), cB, voffB); PG8_STAGE(PG8_SB(0, 1), cB + hstepB, voffB); PG8_STAGE(PG8_SA(0, 0), cA, voffA); PG8_STAGE(PG8_SA(0, 1), cA + hstep, voffA);
        if (wr == 1) PG8_BAR;
        PG8_WAIT_V(2); PG8_BAR;
        PG8_STAGE(PG8_SB(1, 0), cB + kstep, voffB); PG8_STAGE(PG8_SA(1, 0), cA + kstep, voffA); PG8_STAGE(PG8_SB(1, 1), cB + hstepB + kstep, voffB);
        PG8_WAIT_V(6); PG8_BAR;
    } else {
        PG8_STAGE(PG8_SB(0, 0), cB, voffB); PG8_STAGE(PG8_SA(0, 0), cA, voffA); PG8_STAGE(PG8_SB(0, 1), cB + hstepB, voffB); PG8_STAGE(PG8_SA(0, 1), cA + hstep, voffA);
        if (wr == 1) PG8_BAR;
        PG8_WAIT_V(4); PG8_BAR;
        PG8_STAGE(PG8_SB(1, 0), cB + kstep, voffB); PG8_STAGE(PG8_SA(1, 0), cA + kstep, voffA); PG8_STAGE(PG8_SB(1, 1), cB + hstepB + kstep, voffB);
        PG8_WAIT_V(6); PG8_BAR;
    }
    for (;;) {
        const bool has_next = S.next(ui + 1, nxt);
        const char* nA = has_next ? (const char*)g.A + (size_t)nxt.pm * tstep : cA; const char* nB = has_next ? PG8_BBASE(nxt.pn) : cB;
        for (int t = 0; t < nt; t += 2) {
            if constexpr (Epi::MIDK) { if (t == nt / 2) E.mid(acc, cur, wr, wc, fr, fq); }
            const bool last = (t == nt - 2);
            const char* a1 = cA + (size_t)(t + 1) * kstep;
            const char* a2 = last ? nA : cA + (size_t)(t + 2) * kstep; const char* b2 = last ? nB : cB + (size_t)(t + 2) * kstep;
            const char* a3 = a2 + kstep; const char* b3 = b2 + kstep;
            if (last && has_next) S.a_ready(nxt);
            if constexpr (SP2) {
            PG8_LDB(B0, 0, 0); PG8_LDB(B1, 0, 1); PG8_SCHED; PG8_LDA(At, 0, 0); PG8_STAGE(PG8_SA(1, 1), a1 + hstep, voffA);
            PG8_WAIT_V(8); PG8_WAIT_L(0); PG8_BAR; PG8_MMA(0, 0, At, B0); PG8_MMA(0, 1, At, B1); PG8_BAR; PG8_SCHED;
            PG8_LDA(At, 0, 1); PG8_STAGE(PG8_SB(0, 0), b2, voffB); PG8_STAGE(PG8_SB(0, 1), b2 + hstepB, voffB); PG8_STAGE(PG8_SA(0, 0), a2, voffA);
            PG8_WAIT_V(8); PG8_WAIT_L(0); PG8_BAR; PG8_MMA(1, 0, At, B0); PG8_MMA(1, 1, At, B1); PG8_BAR; PG8_SCHED;
            PG8_LDB(B0, 1, 0); PG8_LDB(B1, 1, 1); PG8_SCHED; PG8_LDA(At, 1, 0); PG8_STAGE(PG8_SA(0, 1), a2 + hstep, voffA);
            PG8_WAIT_V(8); PG8_WAIT_L(0); PG8_BAR; PG8_MMA(0, 0, At, B0); PG8_MMA(0, 1, At, B1); PG8_BAR; PG8_SCHED;
            PG8_LDA(At, 1, 1); PG8_STAGE(PG8_SB(1, 0), b3, voffB); PG8_STAGE(PG8_SB(1, 1), b3 + hstepB, voffB); PG8_STAGE(PG8_SA(1, 0), a3, voffA);
            PG8_WAIT_V(8); PG8_WAIT_L(0); PG8_BAR; PG8_MMA(1, 0, At, B0); PG8_MMA(1, 1, At, B1); PG8_BAR; PG8_SCHED;
            } else {
            PG8_LDB(B0, 0, 0); PG8_SCHED; PG8_LDA(At, 0, 0); PG8_STAGE(PG8_SA(1, 1), a1 + hstep, voffA);
            PG8_WAIT_L(8); PG8_BAR; PG8_WAIT_L(0); PG8_MMA(0, 0, At, B0); PG8_BAR; PG8_SCHED;
            PG8_LDB(B1, 0, 1); PG8_STAGE(PG8_SB(0, 0), b2, voffB);
            PG8_BAR; PG8_WAIT_L(0); PG8_MMA(0, 1, At, B1); PG8_BAR;
            PG8_LDA(At, 0, 1); PG8_STAGE(PG8_SA(0, 0), a2, voffA);
            PG8_BAR; PG8_WAIT_L(0); PG8_MMA(1, 0, At, B0); PG8_BAR; PG8_SCHED;
            PG8_STAGE(PG8_SB(0, 1), b2 + hstepB, voffB);
            PG8_WAIT_V(6); PG8_BAR; PG8_MMA(1, 1, At, B1); PG8_BAR;
            PG8_LDB(B0, 1, 0); PG8_SCHED; PG8_LDA(At, 1, 0); PG8_STAGE(PG8_SA(0, 1), a2 + hstep, voffA);
            PG8_WAIT_L(8); PG8_BAR; PG8_WAIT_L(0); PG8_MMA(0, 0, At, B0); PG8_BAR; PG8_SCHED;
            PG8_LDB(B1, 1, 1); PG8_STAGE(PG8_SB(1, 0), b3, voffB);
            PG8_BAR; PG8_WAIT_L(0); PG8_MMA(0, 1, At, B1); PG8_BAR;
            PG8_LDA(At, 1, 1); PG8_STAGE(PG8_SA(1, 0), a3, voffA);
            PG8_BAR; PG8_WAIT_L(0); PG8_MMA(1, 0, At, B0); PG8_BAR; PG8_SCHED;
            PG8_STAGE(PG8_SB(1, 1), b3 + hstepB, voffB);
            PG8_WAIT_V(6); PG8_BAR; PG8_MMA(1, 1, At, B1); PG8_BAR;
            }
        }
        if constexpr (ALIGN_EPI) { if (wr == 0) PG8_BAR; }
        if constexpr (!Epi::AFTER_DRAIN) { E(acc, cur, wr, wc, fr, fq); S.done(cur); }
        if (!has_next) break;
#pragma unroll
        for (int a = 0; a < 2; ++a)
#pragma unroll
            for (int b = 0; b < 2; ++b)
#pragma unroll
                for (int m = 0; m < 4; ++m)
#pragma unroll
                    for (int n = 0; n < 2; ++n) acc[a][b][m][n] = (f32x4){0.f, 0.f, 0.f, 0.f};
        cur = nxt; cA = nA; cB = nB; ++ui;
        if constexpr (ALIGN_EPI) { if (wr == 1) PG8_BAR; }
    }
    PG8_WAIT_V(0);
    if constexpr (!ALIGN_EPI) { if (wr == 0) PG8_BAR; }
    PG8_BAR;
    if constexpr (Epi::AFTER_DRAIN) { E.fused(acc, cur, wr, wc, fr, fq, lds, wid, lane); S.done(cur); }
#undef PG8_SA
#undef PG8_BBASE
#undef PG8_SB
#undef PG8_STAGE
#undef PG8_LDA
#undef PG8_LDB
#undef PG8_MMA
#undef PG8_WAIT_V
#undef PG8_WAIT_L
#undef PG8_BAR
#undef PG8_SCHED
}
}
using pg8::bf16_t; using pg8::bf16x8; using pg8::f32x4; using pg8::u32x4;
typedef unsigned u32x2 __attribute__((ext_vector_type(2)));
constexpr int NWAVES = 8;
constexpr int M_TOK = 16384, DM = 1024, SEQ = 2048, DEPTH = 4, IN_COLS = 9216;
constexpr int N_MAIN = 7168, N_SW = 2048;
constexpr float EPS = 1e-6f;
constexpr float LOG2E = 1.4426950408889634f;
constexpr float QSCALE = 0.125f * LOG2E;
constexpr size_t MiB = 1u << 20;
constexpr size_t WS_XSQ = 0;
constexpr size_t WS_VSQ = 512 * 1024;
constexpr size_t WS_BAR = 768 * 1024;
constexpr size_t WS_WM = 1 * MiB;
constexpr size_t WS_WT_MAIN = 2 * MiB;
constexpr size_t WS_WT_SW = 58 * MiB;
constexpr size_t WS_WT_A = 74 * MiB, WS_WT_B = 82 * MiB, WS_WT_O = 90 * MiB;
constexpr size_t WS_XB = 98 * MiB, WS_XBP = 130 * MiB;
constexpr size_t WS_ACT = 162 * MiB;
constexpr size_t ACT_STRIDE = (size_t)M_TOK * DM;
constexpr int P_T = M_TOK + 64;
constexpr int P_K = DM + 64;
constexpr size_t WS_GVT = 386 * MiB, WS_VT = 419 * MiB;
constexpr size_t WS_T = 452 * MiB;
constexpr size_t WS_MG = 516 * MiB;
constexpr size_t WS_END = 550 * MiB;
constexpr int RING_BYTES = 131072, LDS_BYTES = 147456;

#define GAS __attribute__((address_space(1)))
#define LAS __attribute__((address_space(3)))

__device__ __forceinline__ float bf2f(unsigned short h) { return __builtin_bit_cast(float, (unsigned)h << 16); }
__device__ __forceinline__ float bflo(unsigned w) { return __builtin_bit_cast(float, w << 16); }
__device__ __forceinline__ float bfhi(unsigned w) { return __builtin_bit_cast(float, w & 0xffff0000u); }
__device__ __forceinline__ unsigned pkbf(float lo, float hi) { return pg8::cvt_pk_bf16(lo, hi); }
__device__ __forceinline__ float sigm(float z) { return __builtin_amdgcn_rcpf(1.f + __builtin_amdgcn_exp2f(-LOG2E * z)); }
__device__ __forceinline__ float gelu_t(float v) { const float z = 1.5957691216057308f * v * (1.f + 0.044715f * v * v); return v * sigm(z); }
__device__ __forceinline__ float rs_of(float ss) { return __builtin_amdgcn_rsqf(ss * (1.0f / 1024.0f) + EPS); }
__device__ __forceinline__ int pi_row(int row) { return (row & ~2047) | ((row & 3) << 9) | ((row & 2047) >> 2); }
__device__ __forceinline__ int pi_inv(int p) { return (p & ~2047) | ((p & 511) << 2) | ((p >> 9) & 3); }

__device__ __forceinline__ size_t cm_off(int p, int chan) { return ((size_t)((((p >> 11) * 4 + ((p >> 9) & 3)) * 16 + ((p >> 5) & 15)) * 1024 + chan)) * 32 + (p & 31); }
__device__ __forceinline__ size_t kb_off(int row, int col) { const int b = row >> 11, tl = row & 2047; return (size_t)(((((b * 16 + (col >> 6)) * 4 + (tl & 3)) * 16 + (tl >> 7)) * 32 + ((tl >> 2) & 31))) * 64 + (col & 63); }
struct EpiMain {
    static constexpr bool PERM = true, AFTER_DRAIN = false, MIDK = false;
    bf16_t* O; const float* xsq; bf16_t* KB;
    __device__ __forceinline__ void operator()(const f32x4 (&acc)[2][2][4][2], const pg8::Unit& u, int wr, int wc, int fr, int fq) const {
        asm volatile("" : "+v"(fr), "+v"(fq));
        const int seg = u.pn >> 2;
        bf16_t* base = O + (size_t)seg * ACT_STRIDE;
        const int col0 = (u.pn & 3) * 256 + wc * 32 + 8 * fq, row0 = u.pm * 256 + wr * 64 + fr;
        const float lin = seg == 2 ? QSCALE : 1.f;
#pragma unroll
        for (int ai = 0; ai < 2; ++ai)
#pragma unroll
            for (int m = 0; m < 4; ++m) { const int row = row0 + ai * 128 + m * 16; const float rs = rs_of(xsq[row]); const float rl = rs * lin; bf16_t* rowp = seg == 3 ? KB + kb_off(row, col0) : base + (size_t)row * DM + col0;
#pragma unroll
                for (int bj = 0; bj < 2; ++bj) { float v[8];
                    if (seg >= 5) {
#pragma unroll
                        for (int e = 0; e < 4; ++e) { v[e] = sigm(acc[ai][bj][m][0][e] * rs); v[4 + e] = sigm(acc[ai][bj][m][1][e] * rs); }
                    } else {
#pragma unroll
                        for (int e = 0; e < 4; ++e) { v[e] = acc[ai][bj][m][0][e] * rl; v[4 + e] = acc[ai][bj][m][1][e] * rl; }
                    }
                    u32x4 w; w.x = pkbf(v[0], v[1]); w.y = pkbf(v[2], v[3]); w.z = pkbf(v[4], v[5]); w.w = pkbf(v[6], v[7]);
                    *(u32x4*)(rowp + (seg == 3 ? 2 * 32 * 16 * 4 * 64 * bj : 128 * bj)) = w; } }
    }
};
struct EpiSw {
    static constexpr bool PERM = true, AFTER_DRAIN = false, MIDK = false;
    bf16_t* GVT; bf16_t* VT; const float* xsq; float* vsq;
    __device__ __forceinline__ void operator()(const f32x4 (&acc)[2][2][4][2], const pg8::Unit& u, int wr, int wc, int fr, int fq) const {
        asm volatile("" : "+v"(fr), "+v"(fq));
        const int colbase = u.pn * 256 + wc * 32 + 8 * fq;
        float cs[2][8];
#pragma unroll
        for (int bj = 0; bj < 2; ++bj)
#pragma unroll
            for (int e = 0; e < 8; ++e) cs[bj][e] = rs_of(xsq[pi_inv(colbase + bj * 128 + e)]);
        const bool isv = u.pm >= 4;
        bf16_t* out = isv ? VT : GVT; const int chan0 = (isv ? u.pm - 4 : u.pm) * 256;
        const int row0 = wr * 64 + fr;
        float ss[2][8];
#pragma unroll
        for (int bj = 0; bj < 2; ++bj)
#pragma unroll
            for (int e = 0; e < 8; ++e) ss[bj][e] = 0.f;
#pragma unroll
        for (int ai = 0; ai < 2; ++ai)
#pragma unroll
            for (int m = 0; m < 4; ++m) { bf16_t* rowp = out + cm_off(colbase, chan0 + row0 + ai * 128 + m * 16);
#pragma unroll
                for (int bj = 0; bj < 2; ++bj) { float v[8];
#pragma unroll
                    for (int e = 0; e < 4; ++e) { v[e] = acc[ai][bj][m][0][e] * cs[bj][e]; v[4 + e] = acc[ai][bj][m][1][e] * cs[bj][4 + e]; }
                    if (!isv) {
#pragma unroll
                        for (int e = 0; e < 8; ++e) { v[e] = gelu_t(v[e]); ss[bj][e] += v[e] * v[e]; } }
                    u32x4 w; w.x = pkbf(v[0], v[1]); w.y = pkbf(v[2], v[3]); w.z = pkbf(v[4], v[5]); w.w = pkbf(v[6], v[7]);
                    *(u32x4*)(rowp + bj * 4 * 1024 * 32) = w; } }
        if (!isv) {
            float mine = 0.f;
#pragma unroll
            for (int bj = 0; bj < 2; ++bj)
#pragma unroll
                for (int e = 0; e < 8; ++e) { float s = ss[bj][e];
                    s += __shfl_xor(s, 1); s += __shfl_xor(s, 2); s += __shfl_xor(s, 4); s += __shfl_xor(s, 8);
                    if (fr == bj * 8 + e) mine = s; }
            atomicAdd(vsq + colbase + (fr >> 3) * 128 + (fr & 7), mine);
        }
    }
};
struct EpiMerge2 {
    static constexpr bool PERM = true, AFTER_DRAIN = false, MIDK = true;
    const bf16_t* GA; const bf16_t* GB; bf16_t* MG;
    __device__ __forceinline__ void mid(f32x4 (&acc)[2][2][4][2], const pg8::Unit& u, int wr, int wc, int fr, int fq) const {
        asm volatile("" : "+v"(fr), "+v"(fq));
        const int col0 = u.pn * 256 + wc * 32 + 8 * fq, row0 = u.pm * 256 + wr * 64 + fr;
#pragma unroll
        for (int ai = 0; ai < 2; ++ai)
#pragma unroll
            for (int m = 0; m < 4; ++m)
#pragma unroll
                for (int bj = 0; bj < 2; ++bj) { const size_t off = (size_t)(row0 + ai * 128 + m * 16) * DM + col0 + bj * 128;
                    const u32x4 ga = *(const u32x4*)(GA + off), gb = *(const u32x4*)(GB + off);
                    f32x4 r0, r1;
                    r0[0] = bflo(ga.x) * __builtin_amdgcn_rcpf(bflo(gb.x)); r0[1] = bfhi(ga.x) * __builtin_amdgcn_rcpf(bfhi(gb.x)); r0[2] = bflo(ga.y) * __builtin_amdgcn_rcpf(bflo(gb.y)); r0[3] = bfhi(ga.y) * __builtin_amdgcn_rcpf(bfhi(gb.y));
                    r1[0] = bflo(ga.z) * __builtin_amdgcn_rcpf(bflo(gb.z)); r1[1] = bfhi(ga.z) * __builtin_amdgcn_rcpf(bfhi(gb.z)); r1[2] = bflo(ga.w) * __builtin_amdgcn_rcpf(bflo(gb.w)); r1[3] = bfhi(ga.w) * __builtin_amdgcn_rcpf(bfhi(gb.w));
                    acc[ai][bj][m][0] = acc[ai][bj][m][0] * r0; acc[ai][bj][m][1] = acc[ai][bj][m][1] * r1; }
    }
    __device__ __forceinline__ void operator()(const f32x4 (&acc)[2][2][4][2], const pg8::Unit& u, int wr, int wc, int fr, int fq) const {
        asm volatile("" : "+v"(fr), "+v"(fq));
        const int col0 = u.pn * 256 + wc * 32 + 8 * fq, row0 = u.pm * 256 + wr * 64 + fr;
#pragma unroll
        for (int ai = 0; ai < 2; ++ai)
#pragma unroll
            for (int m = 0; m < 4; ++m)
#pragma unroll
                for (int bj = 0; bj < 2; ++bj) { const size_t off = (size_t)(row0 + ai * 128 + m * 16) * DM + col0 + bj * 128;
                    const u32x4 g = *(const u32x4*)(GB + off);
                    f32x4 a, b; a[0] = bflo(g.x); a[1] = bfhi(g.x); a[2] = bflo(g.y); a[3] = bfhi(g.y); b[0] = bflo(g.z); b[1] = bfhi(g.z); b[2] = bflo(g.w); b[3] = bfhi(g.w);
                    const f32x4 r0 = a * acc[ai][bj][m][0], r1 = b * acc[ai][bj][m][1];
                    u32x4 w; w.x = pkbf(r0[0], r0[1]); w.y = pkbf(r0[2], r0[3]); w.z = pkbf(r1[0], r1[1]); w.w = pkbf(r1[2], r1[3]);
                    *(u32x4*)(MG + off) = w; }
    }
};
struct EpiOut {
    static constexpr bool PERM = true, AFTER_DRAIN = false, MIDK = false;
    bf16_t* xb; float* xout; float* xsq_next;
    __device__ __forceinline__ void operator()(const f32x4 (&acc)[2][2][4][2], const pg8::Unit& u, int wr, int wc, int fr, int fq) const {
        asm volatile("" : "+v"(fr), "+v"(fq));
        const int col0 = u.pn * 256 + wc * 32 + 8 * fq, row0 = u.pm * 256 + wr * 64 + fr;
#pragma unroll
        for (int ai = 0; ai < 2; ++ai)
#pragma unroll
            for (int m = 0; m < 4; ++m) { const int row = row0 + ai * 128 + m * 16; float ss = 0.f;
#pragma unroll
                for (int bj = 0; bj < 2; ++bj) { const size_t off = (size_t)row * DM + col0 + bj * 128;
                    const u32x4 xi = *(const u32x4*)(xb + off);
                    f32x4 r0, r1; r0[0] = bflo(xi.x); r0[1] = bfhi(xi.x); r0[2] = bflo(xi.y); r0[3] = bfhi(xi.y); r1[0] = bflo(xi.z); r1[1] = bfhi(xi.z); r1[2] = bflo(xi.w); r1[3] = bfhi(xi.w);
                    r0 = r0 + acc[ai][bj][m][0]; r1 = r1 + acc[ai][bj][m][1];
                    ss += (r0[0] * r0[0] + r0[1] * r0[1]) + (r0[2] * r0[2] + r0[3] * r0[3]) + (r1[0] * r1[0] + r1[1] * r1[1]) + (r1[2] * r1[2] + r1[3] * r1[3]);
                    if (xout) { *(f32x4*)(xout + off) = r0; *(f32x4*)(xout + off + 4) = r1; }
                    else { u32x4 w; w.x = pkbf(r0[0], r0[1]); w.y = pkbf(r0[2], r0[3]); w.z = pkbf(r1[0], r1[1]); w.w = pkbf(r1[2], r1[3]); *(u32x4*)(xb + off) = w; } }
                ss += __shfl_xor(ss, 16); ss += __shfl_xor(ss, 32);
                if (fq == 0) atomicAdd(xsq_next + row, ss); }
    }
};
struct MixP { const bf16_t* WM; const bf16_t* GVT; const bf16_t* VT; const bf16_t* K; bf16_t* U; bf16_t* Q; const bf16_t* AG; const bf16_t* BG; const float* vsq; const float* b_s; const float* g_v; bf16_t* UO; bf16_t* QO; };
#define MFMA16(a, b, c) __builtin_amdgcn_mfma_f32_16x16x32_bf16((a), (b), (c), 0, 0, 0)

__device__ __forceinline__ void gating_stage(const MixP& p, int itw, LAS unsigned char* buf, int wave, int lane) {
    const int g = itw & 7, c = (itw >> 3) & 15, b = itw >> 7, r16 = lane >> 2, pp = lane & 3;
#pragma unroll
    for (int q = 0; q < 4; ++q) { const int chunk = wave * 4 + q, dt = chunk >> 2, ks = chunk & 3;
        const bf16_t* src = p.GVT + ((size_t)(((b * 4 + ks) * 16 + c) * 1024 + g * 128 + 16 * dt + r16)) * 32 + 8 * (pp ^ ((r16 >> 2) & 3));
        __builtin_amdgcn_global_load_lds((const unsigned*)src, (LAS unsigned*)(buf + chunk * 1024), 16, 0, 0); }
}
__device__ __forceinline__ void gating_item(const MixP& p, int layer, int it, int lane, const LAS unsigned char* tile, LAS unsigned char* io) {
    const int tt = it & 7, g = (it >> 3) & 7, c = (it >> 6) & 15, b = it >> 10;
    const int j = lane & 15, kg = lane >> 4;
    const bf16_t* wm = p.WM + ((size_t)((layer * 8 + g) * 128 + 16 * tt + j)) * 128 + 8 * kg;
    const size_t tok0 = (size_t)b * 2048 + 128 * c + 16 * tt;
    { const int rr = lane >> 4, pos = lane & 15;
#pragma unroll
      for (int q = 0; q < 4; ++q) { const int row = 4 * q + rr; const size_t off = (tok0 + row) * DM + g * 128 + 8 * (pos ^ row);
          __builtin_amdgcn_global_load_lds((const unsigned*)(p.U + off), (LAS unsigned*)(io + q * 1024), 16, 0, 0);
          __builtin_amdgcn_global_load_lds((const unsigned*)(p.AG + off), (LAS unsigned*)(io + 4096 + q * 1024), 16, 0, 0); } }
    const int t = 16 * tt + j;
    const float bias = p.b_s[(layer * 8 + g) * 128 + t];
    f32x4 acc[8];
#pragma unroll
    for (int dt = 0; dt < 8; ++dt) acc[dt] = (f32x4){0.f, 0.f, 0.f, 0.f};
    bf16x8 bfr[4];
#pragma unroll
    for (int ks = 0; ks < 4; ++ks) {
        const int pb = b * 2048 + ks * 512 + 32 * c + 8 * kg;
        const u32x4 wraw = *(const u32x4*)(wm + 32 * ks);
        const f32x4 q0 = *(const f32x4*)(p.vsq + pb), q1 = *(const f32x4*)(p.vsq + pb + 4);
        u32x4 bw;
        bw.x = pkbf(bflo(wraw.x) * rs_of(q0[0]), bfhi(wraw.x) * rs_of(q0[1])); bw.y = pkbf(bflo(wraw.y) * rs_of(q0[2]), bfhi(wraw.y) * rs_of(q0[3]));
        bw.z = pkbf(bflo(wraw.z) * rs_of(q1[0]), bfhi(wraw.z) * rs_of(q1[1])); bw.w = pkbf(bflo(wraw.w) * rs_of(q1[2]), bfhi(wraw.w) * rs_of(q1[3]));
        bfr[ks] = __builtin_bit_cast(bf16x8, bw);
    }
#pragma unroll
    for (int ks = 0; ks < 4; ++ks) {
#pragma unroll
        for (int dt = 0; dt < 8; ++dt) { const bf16x8 afr = *(const LAS bf16x8*)(tile + (dt * 4 + ks) * 1024 + (j * 4 + (kg ^ ((j >> 2) & 3))) * 16); acc[dt] = MFMA16(afr, bfr[ks], acc[dt]); }
    }
    asm volatile("s_waitcnt vmcnt(0)" ::: "memory");
#pragma unroll
    for (int dt = 0; dt < 8; ++dt) { const int d4 = g * 128 + 16 * dt + 4 * kg; LAS unsigned char* cell = io + j * 256 + (((2 * dt + (kg >> 1)) ^ j) & 15) * 16 + (kg & 1) * 8;
        const f32x4 gv = *(const f32x4*)(p.g_v + layer * 1024 + d4);
        const u32x2 u2 = *(const LAS u32x2*)cell, a2 = *(const LAS u32x2*)(cell + 4096);
        const float g0 = bflo(a2.x), g1 = bfhi(a2.x), g2 = bflo(a2.y), g3 = bfhi(a2.y);
        const float y0 = gelu_t(bflo(u2.x)) * (acc[dt][0] * gv[0] + bias) * (g0 * sigm(g0)), y1 = gelu_t(bfhi(u2.x)) * (acc[dt][1] * gv[1] + bias) * (g1 * sigm(g1));
        const float y2 = gelu_t(bflo(u2.y)) * (acc[dt][2] * gv[2] + bias) * (g2 * sigm(g2)), y3 = gelu_t(bfhi(u2.y)) * (acc[dt][3] * gv[3] + bias) * (g3 * sigm(g3));
        u32x2 w; w.x = pkbf(y0, y1); w.y = pkbf(y2, y3); *(LAS u32x2*)cell = w; }
    { const int rr = lane >> 4, pos = lane & 15;
#pragma unroll
      for (int q = 0; q < 4; ++q) { const int row = 4 * q + rr; const u32x4 v = *(const LAS u32x4*)(io + q * 1024 + lane * 16);
          *(u32x4*)(p.UO + (tok0 + row) * 2048 + g * 128 + 8 * (pos ^ row)) = v; } }
}

constexpr int ATS = 576;
__device__ __forceinline__ void build_bias_table(LAS float* tbl, int h, int tid) {
    const float slope2 = __builtin_amdgcn_exp2f(-0.5f * (float)(h + 1)) * LOG2E;
    for (int i = tid; i < 4 * ATS; i += NWAVES * 64) { const int res = i / ATS, q = i % ATS - 32, dlt = 4 * q + res;
        const int c = (int)(dlt <= 128) + (int)((res == 0) & (dlt <= 512)) + (int)((dlt & 15) == 0);
        const float lg = c == 3 ? 1.5849625007f : (c == 2 ? 1.f : 0.f);
        tbl[i] = (dlt >= 0 && dlt < 2048 && c > 0) ? (lg - slope2 * (float)dlt) : -INFINITY; }
}
struct KVF { bf16x8 kf[2][2]; bf16x8 vf[4]; };
template <int N> __device__ __forceinline__ void attn_wait_v(bf16x8 (&vf)[4]) { (void)vf; }
__device__ __forceinline__ int kswz(int n) { return ((n >> 1) & 1) | (((n >> 3) & 3) << 1); }
__device__ __forceinline__ void attn_dma(const bf16_t* Kbh, const bf16_t* Vbh, int sc, int rp, int lane, LAS unsigned char* stage) {
    const bf16_t* kblk = Kbh + (size_t)((rp * 16 + sc) * 32) * 64;
    const bf16_t* vblk = Vbh + (size_t)((rp * 16 + sc) * 1024) * 32;
#pragma unroll
    for (int q = 0; q < 4; ++q) { const int n = 8 * q + (lane >> 3), pp = lane & 7;
        __builtin_amdgcn_global_load_lds((const unsigned*)(kblk + n * 64 + 8 * (pp ^ kswz(n))), (LAS unsigned*)(stage + q * 1024), 16, 0, 0); }
#pragma unroll
    for (int q = 0; q < 4; ++q) { const int r = 16 * q + (lane >> 2), pp = lane & 3;
        __builtin_amdgcn_global_load_lds((const unsigned*)(vblk + r * 32 + 8 * (pp ^ ((r >> 2) & 3))), (LAS unsigned*)(stage + (4 + q) * 1024), 16, 0, 0); }
}
__device__ __forceinline__ void attn_fetch(bf16x8 (&kf)[2][2], bf16x8 (&vf)[4], const LAS unsigned char* stage, int lane) {
    const int j = lane & 15, kg = lane >> 4;
#pragma unroll
    for (int a = 0; a < 2; ++a) { const int n = 8 * (j >> 2) + 4 * a + (j & 3);
#pragma unroll
        for (int ks = 0; ks < 2; ++ks) kf[a][ks] = *(const LAS bf16x8*)(stage + n * 128 + ((4 * ks + kg) ^ kswz(n)) * 16); }
#pragma unroll
    for (int dt = 0; dt < 4; ++dt) vf[dt] = *(const LAS bf16x8*)(stage + 4096 + (16 * dt + j) * 64 + (kg ^ ((j >> 2) & 3)) * 16);
}
__device__ __forceinline__ float attn_newmax(float mx, float& m, float& l, f32x4 (&o)[4]) {
    { auto r16 = __builtin_amdgcn_permlane16_swap(__float_as_uint(mx), __float_as_uint(mx), false, false); mx = fmaxf(__uint_as_float(r16[0]), __uint_as_float(r16[1]));
      auto r32 = __builtin_amdgcn_permlane32_swap(__float_as_uint(mx), __float_as_uint(mx), false, false); mx = fmaxf(__uint_as_float(r32[0]), __uint_as_float(r32[1])); }
    const float mnew = fmaxf(m, mx);
    if (__any(mnew > m)) { const float alpha = __builtin_amdgcn_exp2f(m - mnew); l *= alpha;
#pragma unroll
        for (int dt = 0; dt < 4; ++dt) o[dt] = o[dt] * alpha; }
    m = mnew; return mnew;
}
template <int NV> __device__ __forceinline__ void attn_compute(const bf16x8 (&kf)[2][2], bf16x8 (&vf)[4], const LAS float* tb0, const bf16x8 (&qf)[2][2], f32x4 (&o)[2][4], float (&m)[2], float (&l)[2]) {
    bf16x8 pf[2];
#pragma unroll
    for (int qt = 0; qt < 2; ++qt) {
        f32x4 s[2];
#pragma unroll
        for (int a = 0; a < 2; ++a) { s[a] = MFMA16(kf[a][0], qf[qt][0], ((f32x4){0.f, 0.f, 0.f, 0.f})); s[a] = MFMA16(kf[a][1], qf[qt][1], s[a]); }
        const LAS float* tb = tb0 + 16 * qt;
        float sv[8]; float mx = -1e30f;
#pragma unroll
        for (int a = 0; a < 2; ++a)
#pragma unroll
            for (int r = 0; r < 4; ++r) { const float x = s[a][r] + tb[7 - 4 * a - r]; sv[4 * a + r] = x; mx = fmaxf(mx, x); }
        const float mnew = attn_newmax(mx, m[qt], l[qt], o[qt]);
        float ps = 0.f;
#pragma unroll
        for (int e = 0; e < 8; ++e) { sv[e] = __builtin_amdgcn_exp2f(sv[e] - mnew); ps += sv[e]; }
        l[qt] += ps;
        u32x4 pw; pw.x = pkbf(sv[0], sv[1]); pw.y = pkbf(sv[2], sv[3]); pw.z = pkbf(sv[4], sv[5]); pw.w = pkbf(sv[6], sv[7]);
        pf[qt] = __builtin_bit_cast(bf16x8, pw);
    }
    attn_wait_v<NV>(vf);
#pragma unroll
    for (int dt = 0; dt < 4; ++dt)
#pragma unroll
        for (int qt = 0; qt < 2; ++qt) o[qt][dt] = MFMA16(vf[dt], pf[qt], o[qt][dt]);
}
template <int NV> __device__ __forceinline__ void attn_compute_far(const bf16x8 (&kf)[2][2], bf16x8 (&vf)[4], const LAS float* tb0, int j, const bf16x8 (&qf)[2][2], f32x4 (&o)[2][4], float (&m)[2], float (&l)[2]) {
    bf16x8 pf[2];
    const int rs_ = j & 3; const bool r1 = (rs_ & 1) != 0, r2 = (rs_ & 2) != 0;
#pragma unroll
    for (int qt = 0; qt < 2; ++qt) {
        float x[2];
#pragma unroll
        for (int a = 0; a < 2; ++a) { f32x4 s = MFMA16(kf[a][0], qf[qt][0], ((f32x4){0.f, 0.f, 0.f, 0.f})); s = MFMA16(kf[a][1], qf[qt][1], s);
            const float lo = r1 ? s[1] : s[0], hi = r1 ? s[3] : s[2]; x[a] = (r2 ? hi : lo) + tb0[16 * qt + 7 - 4 * a - rs_]; }
        const float mnew = attn_newmax(fmaxf(x[0], x[1]), m[qt], l[qt], o[qt]);
        const float p0 = __builtin_amdgcn_exp2f(x[0] - mnew), p1 = __builtin_amdgcn_exp2f(x[1] - mnew);
        l[qt] += p0 + p1;
        const unsigned w0 = pkbf(r1 ? 0.f : p0, r1 ? p0 : 0.f), w1 = pkbf(r1 ? 0.f : p1, r1 ? p1 : 0.f);
        u32x4 pw; pw.x = r2 ? 0u : w0; pw.y = r2 ? w0 : 0u; pw.z = r2 ? 0u : w1; pw.w = r2 ? w1 : 0u;
        pf[qt] = __builtin_bit_cast(bf16x8, pw);
    }
    attn_wait_v<NV>(vf);
#pragma unroll
    for (int dt = 0; dt < 4; ++dt)
#pragma unroll
        for (int qt = 0; qt < 2; ++qt) o[qt][dt] = MFMA16(vf[dt], pf[qt], o[qt][dt]);
}
__device__ __forceinline__ void attn_item(const MixP& p, const LAS float* tbl, int b, int h, int nb, int rho, int lane) {
    const int j = lane & 15, kg = lane >> 4; const size_t rowb = (size_t)b * 2048;
    const bf16_t* Kh = p.K + (size_t)((b * 16 + h) * 4) * 16 * 32 * 64;
    const bf16_t* Vh = p.VT + ((size_t)(b * 4) * 16 * 1024 + h * 64) * 32;
    f32x4 o[2][4]; float m[2] = {-1e30f, -1e30f}, l[2] = {0.f, 0.f};
#pragma unroll
    for (int qt = 0; qt < 2; ++qt)
#pragma unroll
        for (int dt = 0; dt < 4; ++dt) o[qt][dt] = (f32x4){0.f, 0.f, 0.f, 0.f};
    const int lb = 4 * j - 32 * kg, sc0 = nb > 0 ? nb - 1 : 0, nnear = 3 * (nb - sc0 + 1), nst = nb + 1 + nnear;
#define ATT_DECODE(t, sc_, rp_) do { if ((t) == 0) { sc_ = nb; rp_ = rho; } else if ((t) <= nnear) { const int e_ = (t) - 1; sc_ = nb - e_ / 3; rp_ = (rho + 1 + e_ % 3) & 3; } else { sc_ = nb - ((t) - nnear); rp_ = rho; } } while (0)
    LAS unsigned char* ring = (LAS unsigned char*)tbl - (RING_BYTES + 1024) + __builtin_amdgcn_readfirstlane((int)(threadIdx.x >> 6)) * 16384;
    const int R8 = lane >> 3, pos8 = lane & 7;
#define ATT_ROWTOK(R) (rowb + 128 * nb + 64 * ((R) >> 4) + rho + 4 * ((R) & 15))
#pragma unroll
    for (int q = 0; q < 4; ++q) { const int R = 8 * q + R8;
        __builtin_amdgcn_global_load_lds((const unsigned*)(p.Q + ATT_ROWTOK(R) * DM + h * 64 + 8 * (pos8 ^ ((R >> 1) & 7))), (LAS unsigned*)(ring + 8192 + q * 1024), 16, 0, 0); }
    { int sc_, rp_; ATT_DECODE(0, sc_, rp_); attn_dma(Kh, Vh, sc_, rp_, lane, ring); }
    asm volatile("s_waitcnt vmcnt(8)" ::: "memory");
    bf16x8 qf[2][2];
#pragma unroll
    for (int qt = 0; qt < 2; ++qt) { const int R = 16 * qt + j;
#pragma unroll
        for (int ks = 0; ks < 2; ++ks) qf[qt][ks] = *(const LAS bf16x8*)(ring + 8192 + R * 128 + ((4 * ks + kg) ^ ((R >> 1) & 7)) * 16); }
    asm volatile("s_waitcnt lgkmcnt(0)" : "+v"(qf[0][0]), "+v"(qf[0][1]), "+v"(qf[1][0]), "+v"(qf[1][1]) : : "memory");
    if (nst > 1) { int sc_, rp_; ATT_DECODE(1, sc_, rp_); attn_dma(Kh, Vh, sc_, rp_, lane, ring + 8192); }
    for (int t = 0; t < nst; ++t) {
        LAS unsigned char* stage = ring + (t & 1) * 8192;
        if (t + 1 < nst) asm volatile("s_waitcnt vmcnt(8)" ::: "memory"); else asm volatile("s_waitcnt vmcnt(0)" ::: "memory");
        bf16x8 kf[2][2], vf[4];
        attn_fetch(kf, vf, stage, lane);
        asm volatile("s_waitcnt lgkmcnt(0)" : "+v"(kf[0][0]), "+v"(kf[0][1]), "+v"(kf[1][0]), "+v"(kf[1][1]), "+v"(vf[0]), "+v"(vf[1]), "+v"(vf[2]), "+v"(vf[3]) : : "memory");
        if (t + 2 < nst) { int sc_, rp_; ATT_DECODE(t + 2, sc_, rp_); attn_dma(Kh, Vh, sc_, rp_, lane, stage); }
        if (t + 1 == nst) {
#pragma unroll
            for (int q = 0; q < 4; ++q) { const int R = 8 * q + R8;
                __builtin_amdgcn_global_load_lds((const unsigned*)(p.BG + ATT_ROWTOK(R) * DM + h * 64 + 8 * (pos8 ^ ((R >> 1) & 7))), (LAS unsigned*)(ring + ((t + 1) & 1) * 8192 + q * 1024), 16, 0, 0); } }
        int sc_, rp_; ATT_DECODE(t, sc_, rp_);
        const int d0 = 128 * (nb - sc_) + (rho - rp_) + lb; const LAS float* tb0 = tbl + ((d0 & 3) * ATS + (d0 >> 2) + 32 - 7);
        if (nb - sc_ >= 5) attn_compute_far<0>(kf, vf, tb0, j, qf, o, m, l); else attn_compute<0>(kf, vf, tb0, qf, o, m, l);
    }
#undef ATT_DECODE
    asm volatile("s_waitcnt vmcnt(0)" ::: "memory");
    LAS unsigned char* bgst = ring + (nst & 1) * 8192; LAS unsigned char* outst = ring + ((nst + 1) & 1) * 8192;
#pragma unroll
    for (int qt = 0; qt < 2; ++qt) { float lt = l[qt]; lt += __shfl_xor(lt, 16); lt += __shfl_xor(lt, 32); const float inv = 1.0f / lt;
        const int R = 16 * qt + j;
#pragma unroll
        for (int dt = 0; dt < 4; ++dt) { const int cell = R * 128 + (((2 * dt + (kg >> 1)) ^ ((R >> 1) & 7)) * 16) + (kg & 1) * 8;
            const u32x2 g2 = *(const LAS u32x2*)(bgst + cell);
            const float b0 = bflo(g2.x), b1 = bfhi(g2.x), b2 = bflo(g2.y), b3 = bfhi(g2.y);
            u32x2 w; w.x = pkbf(o[qt][dt][0] * inv * (b0 * sigm(b0)), o[qt][dt][1] * inv * (b1 * sigm(b1))); w.y = pkbf(o[qt][dt][2] * inv * (b2 * sigm(b2)), o[qt][dt][3] * inv * (b3 * sigm(b3)));
            *(LAS u32x2*)(outst + cell) = w; } }
#pragma unroll
    for (int q = 0; q < 4; ++q) { const int R = 8 * q + R8; const u32x4 v = *(const LAS u32x4*)(outst + q * 1024 + lane * 16);
        *(u32x4*)(p.QO + ATT_ROWTOK(R) * 2048 + h * 64 + 8 * (pos8 ^ ((R >> 1) & 7))) = v; }
    asm volatile("s_waitcnt lgkmcnt(0)" ::: "memory");
#undef ATT_ROWTOK
}

__device__ __forceinline__ float wave_sum(float v) {
#pragma unroll
    for (int o = 1; o < 64; o <<= 1) v += __shfl_xor(v, o);
    return v;
}
__device__ __forceinline__ void tr_tile(const float* W, int N, int k0, int n0, const float* gk, bf16_t* dst, int K, LAS float* scr, int lane) {
#pragma unroll 8
    for (int i = 0; i < 32; ++i) { const int kk = 2 * i + (lane >> 5); float v = W[(size_t)(k0 + kk) * N + n0 + (lane & 31)]; if (gk) v *= gk[k0 + kk]; scr[kk * 33 + (lane & 31)] = v; }
    asm volatile("s_waitcnt lgkmcnt(0)" ::: "memory");
    const int c = lane & 7;
#pragma unroll
    for (int jj = 0; jj < 4; ++jj) { const int n = (lane >> 3) + 8 * jj; const LAS float* s = scr + (8 * c) * 33 + n;
        u32x4 o; o.x = pkbf(s[0 * 33], s[1 * 33]); o.y = pkbf(s[2 * 33], s[3 * 33]); o.z = pkbf(s[4 * 33], s[5 * 33]); o.w = pkbf(s[6 * 33], s[7 * 33]);
        *(u32x4*)(dst + (size_t)n * K + k0 + 8 * c) = o; }
    asm volatile("s_waitcnt lgkmcnt(0)" ::: "memory");
}

#define XB_TMO      128
#define XB_XCNT(j)  (256  + 64 * (j))
#define XB_XSUB(j)  (1280 + 64 * (j))
#define XB_XGEN(j)  (2304 + 64 * (j))
#define XB_TOP      3328
#define XB_TOPGEN   3392
#define XCD_BAR_WORDS 3456
#define XB_SPIN_CAP (1u << 18)

__device__ __forceinline__ unsigned xb_ld(unsigned* p)              { return __hip_atomic_load(p, __ATOMIC_RELAXED, __HIP_MEMORY_SCOPE_AGENT); }
__device__ __forceinline__ unsigned xb_add(unsigned* p, unsigned v) { return __hip_atomic_fetch_add(p, v, __ATOMIC_RELAXED, __HIP_MEMORY_SCOPE_AGENT); }
__device__ __forceinline__ unsigned xb_xcc_id() { return (unsigned)__builtin_amdgcn_s_getreg((3 << 11) | 20) & 0xFu; }
#define XB_SPIN(cond, bar) do { unsigned _sp = 0; while (cond) { __builtin_amdgcn_s_sleep(1); \
    if ((++_sp & 255u) == 0u) { if (xb_ld(&(bar)[XB_TMO])) break; if (_sp > XB_SPIN_CAP) { atomicAdd(&(bar)[XB_TMO], 1u); break; } } } } while (0)

struct XcdBarrier {
    unsigned* bar; unsigned x;
    volatile LAS unsigned* st;
};

__device__ __forceinline__ XcdBarrier xcd_barrier_post(unsigned* bar, volatile LAS unsigned* st) {
    XcdBarrier b; b.bar = bar; b.x = xb_xcc_id(); b.st = st;
    if (threadIdx.x == 0) st[2] = xb_add(&bar[XB_XCNT(b.x)], 1u);
    return b;
}
__device__ __forceinline__ void xcd_barrier_complete(unsigned* bar, unsigned x, unsigned& nloc, unsigned& nx) {
    const unsigned G = gridDim.x * gridDim.y * gridDim.z;
    unsigned sum, cnt, mine, sp = 0u;
    for (;;) {
        sum = 0u; cnt = 0u; mine = 0u;
#pragma unroll
        for (unsigned j = 0; j < 16; ++j) { const unsigned c = xb_ld(&bar[XB_XCNT(j)]); sum += c; cnt += (c > 0u) ? 1u : 0u; mine = (j == x) ? c : mine; }
        if (sum == G) break;
        __builtin_amdgcn_s_sleep(1);
        if ((++sp & 255u) == 0u) { if (xb_ld(&bar[XB_TMO])) break; if (sp > XB_SPIN_CAP) { atomicAdd(&bar[XB_TMO], 1u); break; } }
    }
    nloc = mine > 0u ? mine : 1u; nx = cnt > 0u ? cnt : 1u;
}

__device__ __forceinline__ void xcd_barrier(const XcdBarrier& b) {
    asm volatile("s_waitcnt vmcnt(0)" ::: "memory");
    __syncthreads();
    if (threadIdx.x == 0) {
        unsigned* bar = b.bar;
        __builtin_amdgcn_s_waitcnt(0);
        unsigned nloc = b.st[0], nx = b.st[1];
        if (nloc == 0u) { xcd_barrier_complete(bar, b.x, nloc, nx); b.st[0] = nloc; b.st[1] = nx; }
        const unsigned old = xb_add(&bar[XB_XSUB(b.x)], 1u);
        const unsigned gen = old / nloc;
        if (old + 1u == (gen + 1u) * nloc) {
            __builtin_amdgcn_fence(__ATOMIC_RELEASE, "agent");
            asm volatile("s_waitcnt vmcnt(0)" ::: "memory");
            const unsigned og = xb_add(&bar[XB_TOP], 1u);
            const unsigned tg = og / nx;
            if (og + 1u == (tg + 1u) * nx) xb_add(&bar[XB_TOPGEN], 1u);
            else XB_SPIN(xb_ld(&bar[XB_TOPGEN]) == tg, bar);
            __builtin_amdgcn_fence(__ATOMIC_ACQUIRE, "agent");
            xb_add(&bar[XB_XGEN(b.x)], 1u);
            asm volatile("s_waitcnt vmcnt(0)" ::: "memory");
        } else {
            XB_SPIN(xb_ld(&bar[XB_XGEN(b.x)]) == gen, bar);
            __builtin_amdgcn_fence(__ATOMIC_ACQUIRE, "agent");
            asm volatile("s_waitcnt vmcnt(0)" ::: "memory");
        }
    }
    __syncthreads();
}

__device__ __forceinline__ int lane_id() { int t = threadIdx.x; asm volatile("" : "+v"(t)); return t & 63; }
struct TrDesc { const float* W; const float* gk; bf16_t* dst; int N, k0, n0, K; };
struct TrRegs { f32x4 v[8]; float g[8]; };
__device__ __forceinline__ void tr_load(TrRegs& r, const TrDesc& d, int lane) {
#pragma unroll
    for (int i = 0; i < 8; ++i) { const int kk = 8 * i + (lane >> 3); r.v[i] = *(const f32x4*)(d.W + (size_t)(d.k0 + kk) * d.N + d.n0 + 4 * (lane & 7)); r.g[i] = d.gk ? d.gk[d.k0 + kk] : 1.f; }
}
__device__ __forceinline__ void tr_store(const TrRegs& r, const TrDesc& d, LAS float* scr, int lane) {
#pragma unroll
    for (int i = 0; i < 8; ++i) { const int kk = 8 * i + (lane >> 3); LAS float* sp = scr + kk * 33 + 4 * (lane & 7);
        sp[0] = r.v[i][0] * r.g[i]; sp[1] = r.v[i][1] * r.g[i]; sp[2] = r.v[i][2] * r.g[i]; sp[3] = r.v[i][3] * r.g[i]; }
    asm volatile("s_waitcnt lgkmcnt(0)" ::: "memory");
    const int c = lane & 7;
#pragma unroll
    for (int jj = 0; jj < 4; ++jj) { const int n = (lane >> 3) + 8 * jj; const LAS float* s = scr + (8 * c) * 33 + n;
        u32x4 o; o.x = pkbf(s[0 * 33], s[1 * 33]); o.y = pkbf(s[2 * 33], s[3 * 33]); o.z = pkbf(s[4 * 33], s[5 * 33]); o.w = pkbf(s[6 * 33], s[7 * 33]);
        *(u32x4*)(d.dst + (size_t)n * d.K + d.k0 + 8 * c) = o; }
    asm volatile("s_waitcnt lgkmcnt(0)" ::: "memory");
}
__device__ __forceinline__ TrDesc tr_desc(int it, const float* w_in, const float* g_norm, const float* w_pa, const float* w_pb, const float* w_out, bf16_t* WTM, bf16_t* WTS, bf16_t* WTA, bf16_t* WTO) {
    constexpr int T_IN = 16 * 288, T_SQ = 16 * 32;
    TrDesc d;
    if (it < DEPTH * T_IN) {
        const int l = it / T_IN, r = it % T_IN, kb = r / 288, nbk = r % 288, n0 = 32 * nbk;
        bf16_t* dst;
        if (n0 < 1024) dst = WTM + ((size_t)l * N_MAIN + n0) * DM;
        else if (n0 < 2048) dst = WTS + ((size_t)l * N_SW + (n0 - 1024)) * DM;
        else if (n0 < 5120) dst = WTM + ((size_t)l * N_MAIN + (n0 - 1024)) * DM;
        else if (n0 < 6144) dst = WTS + ((size_t)l * N_SW + 1024 + (n0 - 5120)) * DM;
        else dst = WTM + ((size_t)l * N_MAIN + (n0 - 2048)) * DM;
        d.W = w_in + (size_t)l * DM * IN_COLS; d.gk = g_norm + l * DM; d.dst = dst; d.N = IN_COLS; d.k0 = 64 * kb; d.n0 = n0; d.K = DM;
    } else {
        const int r0 = it - DEPTH * T_IN, which = r0 / (DEPTH * T_SQ), r1 = r0 % (DEPTH * T_SQ), l = r1 / T_SQ, r = r1 % T_SQ, kb = r / 32, nbk = r % 32;
        d.W = (which == 0 ? w_pa : which == 1 ? w_pb : w_out) + (size_t)l * DM * DM; d.gk = nullptr; d.N = DM; d.k0 = 64 * kb; d.n0 = 32 * nbk;
        if (which == 2) { d.dst = WTO + ((size_t)l * DM + 32 * nbk) * DM; d.K = DM; }
        else { d.dst = WTA + ((size_t)l * DM + 32 * nbk) * 2048 + which * 1024; d.K = 2048; }
    }
    return d;
}
struct Args { const float* in[10]; float* out; unsigned char* ws; int ph_lo, ph_hi; };
constexpr int N_PHASES = 2 + 4 * DEPTH;

__global__ void __launch_bounds__(NWAVES * 64, 2) hyb_fwd(Args args) {
    extern __shared__ __attribute__((aligned(16))) unsigned char lds[];
    LAS unsigned char* L = (LAS unsigned char*)lds;
    const int tid = threadIdx.x, wave = __builtin_amdgcn_readfirstlane(tid >> 6);
#define lane lane_id()
    const int G = gridDim.x, bx = blockIdx.x, vcu = (G % 8 == 0) ? (bx % 8) * (G / 8) + bx / 8 : bx;
    const int gw = vcu * NWAVES + wave, NGW = G * NWAVES;
    const float* x_in = args.in[0]; const float* g_norm = args.in[1]; const float* w_in = args.in[2]; const float* w_s = args.in[3]; const float* b_s = args.in[4];
    const float* g_v = args.in[5]; const float* w_pa = args.in[6]; const float* w_pb = args.in[7]; const float* w_out = args.in[8]; const float* g_final = args.in[9];
#define WS_PTRS() unsigned char* ws = args.ws; asm volatile("" : "+s"(ws)); \
    float* xsq = (float*)(ws + WS_XSQ); float* vsq = (float*)(ws + WS_VSQ); \
    bf16_t* WM = (bf16_t*)(ws + WS_WM); bf16_t* WTM = (bf16_t*)(ws + WS_WT_MAIN); bf16_t* WTS = (bf16_t*)(ws + WS_WT_SW); \
    bf16_t* WTA = (bf16_t*)(ws + WS_WT_A); bf16_t* WTB = (bf16_t*)(ws + WS_WT_B); bf16_t* WTO = (bf16_t*)(ws + WS_WT_O); \
    bf16_t* XB = (bf16_t*)(ws + WS_XB); bf16_t* XBP = (bf16_t*)(ws + WS_XBP); bf16_t* ACT = (bf16_t*)(ws + WS_ACT); \
    bf16_t* GVT = (bf16_t*)(ws + WS_GVT); bf16_t* VT = (bf16_t*)(ws + WS_VT); float* T = (float*)(ws + WS_T); bf16_t* MG = (bf16_t*)(ws + WS_MG); \
    bf16_t* bU = ACT; bf16_t* bAG = ACT + ACT_STRIDE; bf16_t* bQ = ACT + 2 * ACT_STRIDE; bf16_t* bK = ACT + 3 * ACT_STRIDE; bf16_t* bBG = ACT + 4 * ACT_STRIDE; \
    bf16_t* bGA = ACT + 5 * ACT_STRIDE; bf16_t* bGB = ACT + 6 * ACT_STRIDE; \
    (void)xsq; (void)vsq; (void)WM; (void)WTM; (void)WTS; (void)WTA; (void)WTB; (void)WTO; (void)XB; (void)XBP; (void)GVT; (void)VT; (void)T; (void)MG; \
    (void)bU; (void)bAG; (void)bQ; (void)bK; (void)bBG; (void)bGA; (void)bGB
    const int lo = args.ph_lo, hi = args.ph_hi;
#define IN(k) (lo <= (k) && (k) < hi)
#define SEAM(k) do { if (IN(k) && IN((k) + 1)) { xcd_barrier(xbar); } } while (0)

    if (IN(0)) {
        WS_PTRS();
        const int lane0 = lane_id();
        LAS float* scr = (LAS float*)(L + wave * 16384);
        constexpr int T_IN = 16 * 288, T_SQ = 16 * 32, NT = DEPTH * (T_IN + 3 * T_SQ);
#define tile_desc(it) tr_desc((it), w_in, g_norm, w_pa, w_pb, w_out, WTM, WTS, WTA, WTO)
        { TrRegs ra, rb;
          if (gw < NT) tr_load(ra, tile_desc(gw), lane0);
          for (int it = gw; it < NT; it += 2 * NGW) {
              const int it1 = it + NGW, it2 = it + 2 * NGW;
              if (it1 < NT) tr_load(rb, tile_desc(it1), lane0);
              tr_store(ra, tile_desc(it), scr, lane0);
              if (it2 < NT) tr_load(ra, tile_desc(it2), lane0);
              if (it1 < NT) tr_store(rb, tile_desc(it1), scr, lane0);
          } }
#undef tile_desc
        for (int m0 = gw; m0 < M_TOK; m0 += 4 * NGW) {
            f32x4 v[4][4];
#pragma unroll
            for (int rr = 0; rr < 4; ++rr) { const int mrow = m0 + rr * NGW; if (mrow < M_TOK) { const f32x4* xr = (const f32x4*)(x_in + (size_t)mrow * DM) + lane0;
#pragma unroll
                for (int q = 0; q < 4; ++q) v[rr][q] = xr[64 * q]; } }
#pragma unroll
            for (int rr = 0; rr < 4; ++rr) { const int mrow = m0 + rr * NGW; if (mrow < M_TOK) { float s = 0.f;
#pragma unroll
                for (int q = 0; q < 4; ++q) s += (v[rr][q][0] * v[rr][q][0] + v[rr][q][1] * v[rr][q][1]) + (v[rr][q][2] * v[rr][q][2] + v[rr][q][3] * v[rr][q][3]);
                s = wave_sum(s);
                u32x2* o1 = (u32x2*)(XB + (size_t)mrow * DM) + lane0;
#pragma unroll
                for (int q = 0; q < 4; ++q) { u32x2 w; w.x = pkbf(v[rr][q][0], v[rr][q][1]); w.y = pkbf(v[rr][q][2], v[rr][q][3]); o1[64 * q] = w; }
                if (lane0 == 0) xsq[mrow] = s; } }
        }
        const int gt = vcu * (NWAVES * 64) + tid, NGT = G * NWAVES * 64;
        for (int i = gt; i < 4 * M_TOK; i += NGT) { xsq[M_TOK + i] = 0.f; vsq[i] = 0.f; }
        for (int i = gt; i < XCD_BAR_WORDS; i += NGT) ((unsigned*)(ws + WS_BAR))[i] = 0u;
        for (int i = gt; i < DEPTH * 8 * 128 * 128; i += NGT) { const int sg = i & 127, t = (i >> 7) & 127, s = (sg & 31) * 4 + (sg >> 5);
            const float v = (s <= t) ? w_s[(size_t)(i >> 14) * 16384 + t * 128 + s] : 0.f; WM[i] = (bf16_t)(pkbf(v, 0.f) & 0xffffu); }
    }
    XcdBarrier xbar; xbar.bar = (unsigned*)(args.ws + WS_BAR); xbar.x = 0; xbar.st = (volatile LAS unsigned*)(L + RING_BYTES + 64);
    if (tid < 2) xbar.st[tid] = 0u;
    if (IN(0) && IN(1)) { __threadfence(); cg::this_grid().sync(); }
    if (hi - lo > 1) xbar = xcd_barrier_post((unsigned*)(args.ws + WS_BAR), (volatile LAS unsigned*)(L + RING_BYTES + 64));

    for (int layer = 0; layer < DEPTH; ++layer) {
        const int ph = 1 + 4 * layer;
        if (IN(ph)) {
            WS_PTRS();
            { pg8::Gemm g{XB, WTM + (size_t)layer * N_MAIN * DM, M_TOK, N_MAIN, DM}; pg8::StaticOrder S; S.init(M_TOK, N_MAIN, G, bx);
              EpiMain E{ACT, xsq + layer * M_TOK, MG};
              pg8::gemm_phase<EpiMain, pg8::StaticOrder, true, true>(L, g, S, E);
              if (DUP & 1) pg8::gemm_phase<EpiMain, pg8::StaticOrder, true, true>(L, g, S, E); }
            { pg8::Gemm g{WTS + (size_t)layer * N_SW * DM, XB, N_SW, M_TOK, DM, 1};     pg8::StaticOrder S; S.init(N_SW, M_TOK, G, bx);
              EpiSw E{GVT, VT, xsq + layer * M_TOK, vsq + layer * M_TOK};
              pg8::gemm_phase<EpiSw, pg8::StaticOrder, true, true>(L, g, S, E); }
        }
        SEAM(ph);
        if (IN(ph + 1)) {
            WS_PTRS(); int ln = lane; asm volatile("" : "+v"(ln));
            MixP p{WM, GVT, VT, (const bf16_t*)MG, bU, bQ, bAG, bBG, vsq + layer * M_TOK, b_s, g_v, (bf16_t*)T, (bf16_t*)T + 1024};
            { int k = 0;
              if (vcu < 1024) gating_stage(p, vcu, L, wave, ln);
              for (int itw = vcu; itw < 1024; itw += G, ++k) {
                  asm volatile("s_waitcnt vmcnt(0)" ::: "memory"); __syncthreads();
                  if (itw + G < 1024) gating_stage(p, itw + G, L + ((k + 1) & 1) * 32768, wave, ln);
                  gating_item(p, layer, itw * 8 + wave, ln, L + (k & 1) * 32768, L + 65536 + wave * 8192);
              }
              __syncthreads(); }
            LAS float* tbl = (LAS float*)(L + RING_BYTES + 1024);
            int vid = vcu;
            if (hi - lo > 1) {
                if (threadIdx.x == 0) { unsigned pre = 0u;
                    for (unsigned jx = 0; jx < 16; ++jx) { const unsigned cx = xb_ld(&xbar.bar[XB_XCNT(jx)]); if (jx < xbar.x) pre += cx; }
                    xbar.st[3] = pre + xbar.st[2]; }
                __syncthreads(); vid = (int)xbar.st[3]; }
            for (int v = vid; v < 256; v += G) {
                const int h = v >> 4, q = (v & 15) * 8 + wave, rho = q & 3, nbsel = (q >> 2) & 15;
                __syncthreads(); build_bias_table(tbl, h, tid); __syncthreads();
                for (int r = 0; r < 4; ++r) {
                    if (DUP & 8) { MixP pd = p; pd.QO = MG; attn_item(pd, tbl, 2 * r + (q >> 6), h, (r & 1) ? 15 - nbsel : nbsel, rho, ln); }
                    attn_item(p, tbl, 2 * r + (q >> 6), h, (r & 1) ? 15 - nbsel : nbsel, rho, ln); }
            }
            __syncthreads();
        }
        SEAM(ph + 1);
        if (IN(ph + 2)) {
            WS_PTRS();
            pg8::Gemm g{(const bf16_t*)T, WTA + (size_t)layer * DM * 2048, M_TOK, DM, 2048}; pg8::StaticOrder S; S.init(M_TOK, DM, G, bx);
            EpiMerge2 E{bGA, bGB, MG}; pg8::gemm_phase<EpiMerge2, pg8::StaticOrder, true, true>(L, g, S, E);
        }
        SEAM(ph + 2);
        if (IN(ph + 3)) {
            WS_PTRS();
            pg8::Gemm g{MG, WTO + (size_t)layer * DM * DM, M_TOK, DM, DM}; pg8::StaticOrder S; S.init(M_TOK, DM, G, bx);
            EpiOut E{XB, layer == DEPTH - 1 ? args.out : nullptr, xsq + (layer + 1) * M_TOK};
            pg8::gemm_phase<EpiOut, pg8::StaticOrder, true, true>(L, g, S, E);
        }
        SEAM(ph + 3);
    }
    if (IN(N_PHASES - 1)) {
        WS_PTRS();
        const float* fs = xsq + DEPTH * M_TOK; const int lane1 = lane_id();
        for (int mrow = gw; mrow < M_TOK; mrow += NGW) { const float rs = rs_of(fs[mrow]); f32x4* xr = (f32x4*)(args.out + (size_t)mrow * DM) + lane1;
#pragma unroll
            for (int q = 0; q < 4; ++q) { const f32x4 gq = *((const f32x4*)g_final + lane1 + 64 * q); xr[64 * q] = xr[64 * q] * rs * gq; } }
    }
#undef IN
#undef SEAM
#undef WS_PTRS
#undef lane
}


extern "C" void kernel_launch(void* const* d_in, const int* in_sizes, int n_in, void* d_out, int out_size, void* d_ws, size_t ws_size, hipStream_t stream) {
    static int grid = 0;
    if (grid == 0) {
        if (n_in != 10 || in_sizes[0] != M_TOK * DM || out_size != M_TOK * DM || ws_size < WS_END) { fprintf(stderr, "kernel_launch: unexpected shapes / workspace (%d inputs, ws %zu, need %zu)\n", n_in, ws_size, (size_t)WS_END); grid = -1; return; }
        int dev = 0, cus = 0, per_cu = 0;
        (void)hipGetDevice(&dev); (void)hipDeviceGetAttribute(&cus, hipDeviceAttributeMultiprocessorCount, dev);
        if (hipFuncSetAttribute((const void*)hyb_fwd, hipFuncAttributeMaxDynamicSharedMemorySize, LDS_BYTES) != hipSuccess) { fprintf(stderr, "kernel_launch: hipFuncSetAttribute failed\n"); grid = -1; return; }
        if (hipOccupancyMaxActiveBlocksPerMultiprocessor(&per_cu, (const void*)hyb_fwd, NWAVES * 64, LDS_BYTES) != hipSuccess || per_cu != 1) per_cu = 1;
        (void)hipGetLastError();
        if (cus <= 0) cus = 256;
        grid = cus * per_cu;
    }
    if (grid < 0) return;
    Args a{};
    for (int i = 0; i < 10; ++i) a.in[i] = (const float*)d_in[i];
    a.out = (float*)d_out; a.ws = (unsigned char*)d_ws;
#if MK_MULTI
    for (int ph = 0; ph < N_PHASES; ++ph) { a.ph_lo = ph; a.ph_hi = ph + 1; hipLaunchKernelGGL(hyb_fwd, dim3(grid), dim3(NWAVES * 64), LDS_BYTES, stream, a); }
#else
    a.ph_lo = 0; a.ph_hi = N_PHASES;
    void* kargs[] = {&a};
    hipError_t e = hipLaunchCooperativeKernel((const void*)hyb_fwd, dim3(grid), dim3(NWAVES * 64), kargs, LDS_BYTES, stream);
    if (e != hipSuccess) fprintf(stderr, "kernel_launch: cooperative launch failed: %s (grid %d)\n", hipGetErrorString(e), grid);
#endif
}
```
